# Optimizing an MI355X kernel written in HIP

```python
import jax, jax.numpy as jnp
from jax import lax
import numpy as np

D_MODEL = 1024
BATCH = 4
SEQ = 8192
DEPTH = 2

CHUNK = 64
D_MIX = D_MODEL
D_MLSTM = D_MIX // 2
N_MLSTM_HEADS = 4
DH_MLSTM = D_MLSTM // N_MLSTM_HEADS
D_LRU = D_MIX - D_MLSTM
N_LRU_BLOCKS = 8
DB_LRU = D_LRU // N_LRU_BLOCKS
CONV_WIDTH = 4
LRU_C = 8.0
D_FF = 2816
N_EXPERTS = 8
TOP_K = 2
N_DENSE = (DEPTH + 1) // 2
N_MOE = DEPTH // 2
EPS = 1e-6
SPLITS = (D_MLSTM, 2 * D_MLSTM, 3 * D_MLSTM, 4 * D_MLSTM,
          4 * D_MLSTM + N_MLSTM_HEADS, 4 * D_MLSTM + 2 * N_MLSTM_HEADS,
          4 * D_MLSTM + 2 * N_MLSTM_HEADS + D_LRU)
D_IN = 4 * D_MLSTM + 2 * N_MLSTM_HEADS + 2 * D_LRU

kernel_name = 'hybrid_mlstm_rglru_moe_trunk'


def _rmsnorm(x, g):
    xf = x.astype(jnp.float32)
    xf = xf * lax.rsqrt(jnp.mean(xf * xf, axis=-1, keepdims=True) + EPS)
    return xf.astype(x.dtype) * g


def _causal_conv(x, w, b):
    S = x.shape[1]
    W = w.shape[0]
    xp = jnp.pad(x, ((0, 0), (W - 1, 0), (0, 0)))
    y = b
    for j in range(W):
        y = y + xp[:, j:j + S, :] * w[j]
    return y


def _mlstm_chunkwise(q, k, v, i_pre, f_pre):
    B, S, H, Dh = q.shape
    NC = S // CHUNK
    f32 = jnp.float32

    def to_chunks(t):
        t = t.astype(f32).reshape((B, NC, CHUNK, H) + t.shape[3:])
        return jnp.moveaxis(t, 3, 1)

    q = to_chunks(q)
    k = to_chunks(k) * (Dh ** -0.5)
    v = to_chunks(v)
    ig = to_chunks(i_pre)
    b = jnp.cumsum(jax.nn.log_sigmoid(to_chunks(f_pre)), axis=-1)
    b_last = b[..., -1]

    w_end = b_last[..., None] - b + ig
    m_loc = jnp.max(w_end, axis=-1)
    e_end = jnp.exp(w_end - m_loc[..., None])
    C_loc = jnp.einsum('bhcsd,bhcse->bhcde', v * e_end[..., None], k)
    n_loc = jnp.einsum('bhcs,bhcse->bhce', e_end, k)

    def step(carry, inp):
        C, n, m = carry
        Cl, nl, ml, bl = inp
        m_new = jnp.maximum(bl + m, ml)
        a = jnp.exp(bl + m - m_new)
        g = jnp.exp(ml - m_new)
        C_new = a[..., None, None] * C + g[..., None, None] * Cl
        n_new = a[..., None] * n + g[..., None] * nl
        return (C_new, n_new, m_new), (C, n, m)

    init = (jnp.zeros((B, H, Dh, Dh), f32), jnp.zeros((B, H, Dh), f32), jnp.zeros((B, H), f32))
    xs = (jnp.moveaxis(C_loc, 2, 0), jnp.moveaxis(n_loc, 2, 0),
          jnp.moveaxis(m_loc, 2, 0), jnp.moveaxis(b_last, 2, 0))
    _, (C_prev, n_prev, m_prev) = lax.scan(step, init, xs)
    C_prev = jnp.moveaxis(C_prev, 0, 2)
    n_prev = jnp.moveaxis(n_prev, 0, 2)
    m_prev = jnp.moveaxis(m_prev, 0, 2)

    causal = jnp.tril(jnp.ones((CHUNK, CHUNK), dtype=bool))
    Dmat = jnp.where(causal, b[..., :, None] - b[..., None, :] + ig[..., None, :], -jnp.inf)
    inter_log = b + m_prev[..., None]
    m_t = jnp.maximum(inter_log, jnp.max(Dmat, axis=-1))
    scores = jnp.einsum('bhctd,bhcsd->bhcts', q, k) * jnp.exp(Dmat - m_t[..., None])
    inter_scale = jnp.exp(inter_log - m_t)
    num = jnp.einsum('bhcts,bhcsd->bhctd', scores, v) \
        + inter_scale[..., None] * jnp.einsum('bhcde,bhcte->bhctd', C_prev, q)
    den = jnp.sum(scores, axis=-1) + inter_scale * jnp.einsum('bhce,bhcte->bhct', n_prev, q)
    h = num / jnp.maximum(jnp.abs(den), jnp.exp(-m_t))[..., None]
    return jnp.moveaxis(h, 1, 3).reshape(B, S, H * Dh)


def _rglru(xl, gl, w_conv, b_conv, w_a, b_a, w_x, b_x, lam):
    B, S, _ = xl.shape
    f32 = jnp.float32
    xc = _causal_conv(xl, w_conv, b_conv)
    xb = xc.reshape(B, S, N_LRU_BLOCKS, DB_LRU)
    r = jax.nn.sigmoid((jnp.einsum('bsnd,nde->bsne', xb, w_a).reshape(B, S, D_LRU) + b_a).astype(f32))
    i = jax.nn.sigmoid((jnp.einsum('bsnd,nde->bsne', xb, w_x).reshape(B, S, D_LRU) + b_x).astype(f32))
    log_a = -LRU_C * r * jax.nn.softplus(-lam.astype(f32))
    a = jnp.exp(log_a)
    u = jnp.sqrt(-jnp.expm1(2.0 * log_a)) * (i * xc.astype(f32))

    def combine(left, right):
        a1, b1 = left
        a2, b2 = right
        return a1 * a2, a2 * b1 + b2

    _, hs = lax.associative_scan(combine, (a, u), axis=1)
    return hs.astype(xl.dtype) * jax.nn.gelu(gl)


def _hybrid_mixer(h, w_in, w_conv_qk, b_conv_qk, b_gates, w_conv_lru, b_conv_lru,
                  w_lru_a, b_lru_a, w_lru_x, b_lru_x, lru_lambda, g_mix_out, w_out):
    B, S, _ = h.shape
    z = h @ w_in
    q, k, v, o, ig, fg, xl, gl = jnp.split(z, SPLITS, axis=-1)
    qk = jax.nn.silu(_causal_conv(jnp.concatenate([q, k], axis=-1), w_conv_qk, b_conv_qk))
    q, k = jnp.split(qk, 2, axis=-1)
    gates = jnp.concatenate([ig, fg], axis=-1) + b_gates
    ig, fg = jnp.split(gates, 2, axis=-1)
    shp = (B, S, N_MLSTM_HEADS, DH_MLSTM)
    hm = _mlstm_chunkwise(q.reshape(shp), k.reshape(shp), v.reshape(shp), ig, fg).astype(h.dtype)
    hm = _rmsnorm(hm.reshape(shp), g_mix_out[:D_MLSTM].reshape(N_MLSTM_HEADS, DH_MLSTM)).reshape(B, S, D_MLSTM)
    hm = hm * jax.nn.sigmoid(o)
    hl = _rglru(xl, gl, w_conv_lru, b_conv_lru, w_lru_a, b_lru_a, w_lru_x, b_lru_x, lru_lambda)
    hl = _rmsnorm(hl, g_mix_out[D_MLSTM:])
    return jnp.concatenate([hm, hl], axis=-1) @ w_out


def _swiglu(h, w_gate, w_up, w_down):
    return (jax.nn.silu(h @ w_gate) * (h @ w_up)) @ w_down


def _moe(h, w_router, b_router, w_g, w_u, w_d):
    logits = (h @ w_router + b_router).astype(jnp.float32)
    top_v, top_i = lax.top_k(logits, TOP_K)
    top_p = jax.nn.softmax(top_v, axis=-1)
    gates = jnp.sum(jax.nn.one_hot(top_i, N_EXPERTS, dtype=jnp.float32) * top_p[..., None], axis=-2).astype(h.dtype)
    y = jnp.zeros_like(h)
    for e in range(N_EXPERTS):
        y = y + gates[..., e:e + 1] * _swiglu(h, w_g[e], w_u[e], w_d[e])
    return y


def setup_inputs(seed: int = 0) -> dict:
    key = jax.random.key(seed)
    ks = jax.random.split(key, 32)
    f32 = jnp.float32

    def nrm(k, shape, scale):
        return jax.random.normal(k, shape, f32) * scale

    D, H = D_MODEL, N_MLSTM_HEADS
    a0 = jax.random.uniform(ks[20], (DEPTH, D_LRU), f32, 0.9, 0.999)
    b_in = nrm(ks[21], (DEPTH, H), 0.1)
    b_fg = 3.0 + 3.0 * jax.random.uniform(ks[22], (DEPTH, H), f32)
    return {
        'x': nrm(ks[0], (BATCH, SEQ, D), 1.0),
        'c': nrm(ks[1], (BATCH, D), 1.0),
        'w_ada': nrm(ks[2], (DEPTH, D, 6 * D), 0.02),
        'b_ada': nrm(ks[3], (DEPTH, 6 * D), 0.02),
        'g_norm_mix': 1.0 + nrm(ks[4], (DEPTH, D), 0.02),
        'g_norm_ffn': 1.0 + nrm(ks[5], (DEPTH, D), 0.02),
        'w_in': nrm(ks[6], (DEPTH, D, D_IN), D ** -0.5),
        'w_conv_qk': nrm(ks[7], (DEPTH, CONV_WIDTH, 2 * D_MLSTM), CONV_WIDTH ** -0.5),
        'b_conv_qk': nrm(ks[8], (DEPTH, 2 * D_MLSTM), 0.02),
        'b_gates': jnp.concatenate([b_in, b_fg], axis=-1),
        'w_conv_lru': nrm(ks[9], (DEPTH, CONV_WIDTH, D_LRU), CONV_WIDTH ** -0.5),
        'b_conv_lru': nrm(ks[10], (DEPTH, D_LRU), 0.02),
        'w_lru_a': nrm(ks[11], (DEPTH, N_LRU_BLOCKS, DB_LRU, DB_LRU), DB_LRU ** -0.5),
        'b_lru_a': nrm(ks[12], (DEPTH, D_LRU), 0.02),
        'w_lru_x': nrm(ks[13], (DEPTH, N_LRU_BLOCKS, DB_LRU, DB_LRU), DB_LRU ** -0.5),
        'b_lru_x': nrm(ks[14], (DEPTH, D_LRU), 0.02),
        'lru_lambda': jnp.log(a0) - jnp.log1p(-a0),
        'g_mix_out': 1.0 + nrm(ks[15], (DEPTH, D_MIX), 0.02),
        'w_out': nrm(ks[16], (DEPTH, D_MIX, D), D_MIX ** -0.5),
        'w_ff_gate': nrm(ks[17], (N_DENSE, D, D_FF), D ** -0.5),
        'w_ff_up': nrm(ks[18], (N_DENSE, D, D_FF), D ** -0.5),
        'w_ff_down': nrm(ks[19], (N_DENSE, D_FF, D), D_FF ** -0.5),
        'w_router': nrm(ks[23], (N_MOE, D, N_EXPERTS), D ** -0.5),
        'b_router': nrm(ks[24], (N_MOE, N_EXPERTS), 0.01),
        'w_exp_gate': nrm(ks[25], (N_MOE, N_EXPERTS, D, D_FF), D ** -0.5),
        'w_exp_up': nrm(ks[26], (N_MOE, N_EXPERTS, D, D_FF), D ** -0.5),
        'w_exp_down': nrm(ks[27], (N_MOE, N_EXPERTS, D_FF, D), D_FF ** -0.5),
        'g_final': 1.0 + nrm(ks[28], (D,), 0.02),
    }


def reference(x, c, w_ada, b_ada, g_norm_mix, g_norm_ffn, w_in, w_conv_qk, b_conv_qk, b_gates,
              w_conv_lru, b_conv_lru, w_lru_a, b_lru_a, w_lru_x, b_lru_x, lru_lambda, g_mix_out, w_out,
              w_ff_gate, w_ff_up, w_ff_down, w_router, b_router, w_exp_gate, w_exp_up, w_exp_down, g_final):
    cond = jax.nn.silu(c)
    for l in range(DEPTH):
        mod = cond @ w_ada[l] + b_ada[l]
        sh_m, sc_m, gt_m, sh_f, sc_f, gt_f = jnp.split(mod[:, None, :], 6, axis=-1)
        h = _rmsnorm(x, g_norm_mix[l]) * (1 + sc_m) + sh_m
        x = x + gt_m * _hybrid_mixer(h, w_in[l], w_conv_qk[l], b_conv_qk[l], b_gates[l],
                                      w_conv_lru[l], b_conv_lru[l], w_lru_a[l], b_lru_a[l],
                                      w_lru_x[l], b_lru_x[l], lru_lambda[l], g_mix_out[l], w_out[l])
        h = _rmsnorm(x, g_norm_ffn[l]) * (1 + sc_f) + sh_f
        j = l // 2
        if l % 2 == 0:
            y = _swiglu(h, w_ff_gate[j], w_ff_up[j], w_ff_down[j])
        else:
            y = _moe(h, w_router[j], b_router[j], w_exp_gate[j], w_exp_up[j], w_exp_down[j])
        x = x + gt_f * y
    return _rmsnorm(x, g_final)
```

```cpp
#include <hip/hip_runtime.h>
#include <cstdio>
#include <cstdint>
namespace pg8 {
#define PG8_LAS __attribute__((address_space(3)))
typedef unsigned short bf16_t;
typedef short bf16x8 __attribute__((ext_vector_type(8)));
typedef float f32x4 __attribute__((ext_vector_type(4)));
typedef unsigned u32x4 __attribute__((ext_vector_type(4)));
typedef unsigned u32x2 __attribute__((ext_vector_type(2)));
constexpr int PG8_SPARE = 132096;
constexpr int BM = 256, BK = 64, HALF = 128, HTB = HALF * BK * 2  , STAGE_BYTES = 8 * HTB, NXCD = 8, WGM = 8;

__host__ __device__ __forceinline__ int lds_byte(int r, int c) { const int st = (r >> 4) * 2 + (c >> 5), rr = r & 15, cc = c & 31, ob = rr * 64 + cc * 2; return st * 1024 + (ob ^ (((ob >> 9) & 1) << 5)); }
__host__ __device__ __forceinline__ void stage_rc(int b, int& R, int& C) { const int st = b / 1024, sb = b % 1024, swz = sb ^ (((sb >> 9) & 1) << 5); R = (st >> 1) * 16 + swz / 64; C = (st & 1) * 32 + (swz % 64) / 2; }
__host__ __device__ __forceinline__ int perm32(int rho) { const int n = rho >> 4, i = rho & 15; return 8 * (i >> 2) + 4 * n + (i & 3); }

struct Unit { int pm, pn, arow, brow, orow, nvalid, kt0, nkt, slice, wt; };
struct Gemm { const bf16_t* A; const bf16_t* Bt; int M, N, K; };

__device__ __forceinline__ int xcd_remap(int wgid, int nwg) { const int q = nwg / NXCD, r = nwg % NXCD, xcd = wgid % NXCD, off = wgid / NXCD; return (xcd < r ? xcd * (q + 1) : r * (q + 1) + (xcd - r) * q) + off; }

struct StaticOrder {
    static constexpr bool FULL = true;
    int nM, nN, nwg, G, c;
    __device__ __forceinline__ void init(int M, int N, int G_, int c_) { nM = M / BM; nN = N / BM; nwg = nM * nN; G = G_; c = c_; }
    __device__ __forceinline__ bool next(int i, Unit& u) const {
        const long L = (long)i * G + c; if (L >= nwg) return false;
        const int wgid = xcd_remap((int)L, nwg);
        const int nig = WGM * nN, gid = wgid / nig, fm = gid * WGM, gsz = (nM - fm) < WGM ? (nM - fm) : WGM;
        u.pm = fm + ((wgid % nig) % gsz); u.pn = (wgid % nig) / gsz; u.arow = u.pm * BM; u.brow = u.pn * BM; u.orow = u.pm * BM; u.nvalid = BM; u.kt0 = 0; u.nkt = 0; u.slice = -1; u.wt = 0; return true;
    }
    __device__ __forceinline__ void a_ready(const Unit&) const {}
    __device__ __forceinline__ void done(const Unit&) const {}
};
struct MoeOrder {
    static constexpr bool FULL = false;
    static constexpr int TAB_OFF = 131584, MAXU = 16;
    const int* tiles; int nT, nN, nwg, G, c; PG8_LAS int* tab;
    __device__ __forceinline__ void init(const int* tiles_, int nT_, int nN_, int G_, int c_, PG8_LAS unsigned char* ldsbase, int wave) { tiles = tiles_; nT = nT_; nN = nN_; nwg = nT * nN; G = G_; c = c_;
        tab = (PG8_LAS int*)(ldsbase + TAB_OFF);
        int ln; asm volatile("v_mbcnt_lo_u32_b32 %0, -1, 0\n\tv_mbcnt_hi_u32_b32 %0, -1, %0" : "=v"(ln));
        __syncthreads();
        if (wave == 0 && ln < MAXU) { const long L = (long)ln * G + c; int d0 = -1, d1 = 0, d2 = 0, d3 = 0;
            if (L < nwg) { const int wgid = xcd_remap((int)L, nwg);
                const int nig = WGM * nN, gid = wgid / nig, fm = gid * WGM, gsz = (nT - fm) < WGM ? (nT - fm) : WGM;
                const int tile = fm + ((wgid % nig) % gsz), pn = (wgid % nig) / gsz;
                d0 = tiles[tile * 4]; d1 = tiles[tile * 4 + 1]; d2 = tiles[tile * 4 + 2]; d3 = tile * 32 + pn; }
            tab[ln * 4] = d0; tab[ln * 4 + 1] = d1; tab[ln * 4 + 2] = d2; tab[ln * 4 + 3] = d3; }
        __syncthreads(); }
    __device__ __forceinline__ bool next(int i, Unit& u) const {
        if (i >= MAXU) return false;
        const int e = __builtin_amdgcn_readfirstlane(tab[i * 4]), rs = __builtin_amdgcn_readfirstlane(tab[i * 4 + 1]), nv = __builtin_amdgcn_readfirstlane(tab[i * 4 + 2]), tp = __builtin_amdgcn_readfirstlane(tab[i * 4 + 3]);
        if (e < 0) return false;
        const int tile = tp >> 5, pn = tp & 31;
        u.pm = tile; u.pn = pn; u.arow = rs; u.brow = e * (nN * BM) + pn * BM; u.orow = rs; u.nvalid = nv; u.kt0 = 0; u.nkt = 0; u.slice = -1; u.wt = 0; return true;
    }
    __device__ __forceinline__ void a_ready(const Unit&) const {}
    __device__ __forceinline__ void done(const Unit&) const {}
};

typedef int i32x4 __attribute__((ext_vector_type(4)));
__device__ __forceinline__ f32x4 mma_acc(bf16x8 b, bf16x8 a, f32x4 c) { return __builtin_amdgcn_mfma_f32_16x16x32_bf16(b, a, c, 0, 0, 0); }
typedef int i32x8 __attribute__((ext_vector_type(8)));
__device__ __forceinline__ f32x4 mma_f8(bf16x8 b0, bf16x8 b1, bf16x8 a0, bf16x8 a1, f32x4 c) {
    const i32x4 bl = __builtin_bit_cast(i32x4, b0), bh = __builtin_bit_cast(i32x4, b1), al = __builtin_bit_cast(i32x4, a0), ah = __builtin_bit_cast(i32x4, a1);
    const i32x8 B = {bl[0], bl[1], bl[2], bl[3], bh[0], bh[1], bh[2], bh[3]}, A = {al[0], al[1], al[2], al[3], ah[0], ah[1], ah[2], ah[3]};
    asm volatile("v_mfma_f32_16x16x128_f8f6f4 %0, %1, %2, %0" : "+v"(c) : "v"(B), "v"(A));
    return c;
}
template <class E, class = void> struct epi_nst { static constexpr int value = 0; };
template <class E> struct epi_nst<E, decltype((void)E::NST)> { static constexpr int value = E::NST; };
template <class E, class = void> struct epi_fp8 { static constexpr bool value = false; };
template <class E> struct epi_fp8<E, decltype((void)E::FP8)> { static constexpr bool value = E::FP8; };
__device__ __forceinline__ unsigned pack_fp8x4(float a, float b, float c, float d, float s) {
    const float a_ = __builtin_amdgcn_fmed3f(a * s, -448.f, 448.f), b_ = __builtin_amdgcn_fmed3f(b * s, -448.f, 448.f), c_ = __builtin_amdgcn_fmed3f(c * s, -448.f, 448.f), d_ = __builtin_amdgcn_fmed3f(d * s, -448.f, 448.f);
    int p = __builtin_amdgcn_cvt_pk_fp8_f32(a_, b_, 0, false); p = __builtin_amdgcn_cvt_pk_fp8_f32(c_, d_, p, true); return (unsigned)p;
}
__device__ __forceinline__ i32x4 mma_acc(bf16x8 b, bf16x8 a, i32x4 c) { return __builtin_amdgcn_mfma_i32_16x16x64_i8(__builtin_bit_cast(i32x4, b), __builtin_bit_cast(i32x4, a), c, 0, 0, 0); }
__device__ __forceinline__ int tail_slices(int R, int G, int ntK, int cap) { int S = G / R; S = S < ntK / 4 ? S : ntK / 4; S = S < cap / R ? S : cap / R; return S; }
struct MoeSliceOrder {
    static constexpr bool FULL = false;
    const int* tiles; int nN, c, tL, tkt0, tnkt;
    __device__ __forceinline__ void init(const int* tiles_, int nT, int nN_, int G, int c_, int ntK, int cap) { tiles = tiles_; nN = nN_; c = c_;
        const int R = nT * nN - 2 * G, S = R > 0 ? tail_slices(R, G, ntK, cap) : 0; tL = -1; tkt0 = 0; tnkt = 0;
        if (R > 0 && c < R * S) { const int e = c / S, k = c % S, pairs = ntK / 2, p0 = pairs * k / S, p1 = pairs * (k + 1) / S;
            tL = __builtin_amdgcn_readfirstlane(2 * G + e); tkt0 = __builtin_amdgcn_readfirstlane(2 * p0); tnkt = __builtin_amdgcn_readfirstlane(2 * (p1 - p0)); } }
    __device__ __forceinline__ bool next(int i, Unit& u) const {
        if (i > 0 || tL < 0) return false;
        const int tile = __builtin_amdgcn_readfirstlane(tL / nN), pn = __builtin_amdgcn_readfirstlane(tL % nN);
        const int e = __builtin_amdgcn_readfirstlane(tiles[tile * 4]), rs = __builtin_amdgcn_readfirstlane(tiles[tile * 4 + 1]), nv = __builtin_amdgcn_readfirstlane(tiles[tile * 4 + 2]);
        u.pm = tile; u.pn = pn; u.arow = rs; u.brow = e * (nN * BM) + pn * BM; u.orow = rs; u.nvalid = nv; u.kt0 = tkt0; u.nkt = tnkt; u.slice = c; u.wt = 0; return true;
    }
    __device__ __forceinline__ void a_ready(const Unit&) const {}
    __device__ __forceinline__ void done(const Unit&) const {}
};
__device__ __forceinline__ unsigned cvt_pk_bf16(float lo, float hi) { unsigned r; asm volatile("v_cvt_pk_bf16_f32 %0, %1, %2" : "=v"(r) : "v"(lo), "v"(hi)); return r; }

#ifndef LAST_WT
#define LAST_WT 1
#endif
#ifndef WT_STORES
#define WT_STORES 0
#endif
__device__ __forceinline__ void st16(void* p, u32x4 v) {
#if WT_STORES
    asm volatile("global_store_dwordx4 %0, %1, off nt\n\ts_nop 1" :: "v"(p), "v"(v) : "memory");
#else
    *(u32x4*)p = v;
#ifdef PROBE_ST2
    asm volatile("global_store_dwordx4 %0, %1, off" :: "v"(p), "v"(v) : "memory");
#endif
#endif
}
__device__ __forceinline__ void st16w(void* p, u32x4 v, int wt) { if (wt) asm volatile("global_store_dwordx4 %0, %1, off sc0 sc1" :: "v"(p), "v"(v) : "memory"); else *(u32x4*)p = v; }
__device__ __forceinline__ void st8w(void* p, u32x2 v, int wt) {
    asm volatile("v_readfirstlane_b32 vcc_lo, %2\n\ts_nop 3\n\ts_cmp_eq_u32 vcc_lo, 0\n\ts_cbranch_scc1 3\n\tglobal_store_dwordx2 %0, %1, off sc0 sc1\n\ts_branch 2\n\tglobal_store_dwordx2 %0, %1, off" :: "v"(p), "v"(v), "v"(wt) : "memory", "scc", "vcc"); }
struct EpiBf16 {
    static constexpr bool PERM = true, AFTER_DRAIN = false, PREFETCH = false, LDSPRE = false; typedef f32x4 acc_t; struct Pre {};
    bf16_t* O; int ldc;
    __device__ __forceinline__ void operator()(const f32x4 (&acc)[2][2][4][2], const Unit& u, int wr, int wc, int fr, int fq) const {
        const int row0 = u.orow + wr * 64 + fr, col0 = u.pn * BM + wc * 32 + 8 * fq;
#pragma unroll
        for (int ai = 0; ai < 2; ++ai)
#pragma unroll
            for (int m = 0; m < 4; ++m) { bf16_t* rowp = O + (size_t)(row0 + ai * HALF + m * 16) * ldc + col0;
#pragma unroll
                for (int bj = 0; bj < 2; ++bj) { const f32x4 v0 = acc[ai][bj][m][0], v1 = acc[ai][bj][m][1];
                    u32x4 w; w.x = cvt_pk_bf16(v0[0], v0[1]); w.y = cvt_pk_bf16(v0[2], v0[3]); w.z = cvt_pk_bf16(v1[0], v1[1]); w.w = cvt_pk_bf16(v1[2], v1[3]);
                    st16(rowp + bj * HALF, w); } }
    }
};
__device__ __forceinline__ float bf_lo(unsigned w) { return __builtin_bit_cast(float, w << 16); }
__device__ __forceinline__ float bf_hi(unsigned w) { return __builtin_bit_cast(float, w & 0xffff0000u); }
struct EpiRes {
    static constexpr bool PERM = true, AFTER_DRAIN = false, PREFETCH = false, LDSPRE = false; typedef f32x4 acc_t; struct Pre {};
    bf16_t* x; const float* gate; float osc;
    __device__ __forceinline__ void operator()(const f32x4 (&acc)[2][2][4][2], const Unit& u, int wr, int wc, int fr, int fq) const {
        const int row0 = u.orow + wr * 64 + fr, col0 = u.pn * BM + wc * 32 + 8 * fq;
        const float* gp = gate + (size_t)(u.orow >> 13) * 6144 + col0;
        f32x4 gv[2][2];
#pragma unroll
        for (int bj = 0; bj < 2; ++bj)
#pragma unroll
            for (int n = 0; n < 2; ++n) gv[bj][n] = *(const f32x4*)(gp + bj * HALF + 4 * n) * osc;
#pragma unroll
        for (int ai = 0; ai < 2; ++ai) {
            u32x4 xin[4][2];
#pragma unroll
            for (int m = 0; m < 4; ++m)
#pragma unroll
                for (int bj = 0; bj < 2; ++bj) xin[m][bj] = *(const u32x4*)(x + (size_t)(row0 + ai * HALF + m * 16) * 1024 + col0 + bj * HALF);
#pragma unroll
            for (int m = 0; m < 4; ++m) { bf16_t* rowp = x + (size_t)(row0 + ai * HALF + m * 16) * 1024 + col0;
#pragma unroll
                for (int bj = 0; bj < 2; ++bj) { const u32x4 xv = xin[m][bj];
                    const f32x4 v0 = (f32x4){bf_lo(xv.x), bf_hi(xv.x), bf_lo(xv.y), bf_hi(xv.y)} + gv[bj][0] * acc[ai][bj][m][0], v1 = (f32x4){bf_lo(xv.z), bf_hi(xv.z), bf_lo(xv.w), bf_hi(xv.w)} + gv[bj][1] * acc[ai][bj][m][1];
                    u32x4 w; w.x = cvt_pk_bf16(v0[0], v0[1]); w.y = cvt_pk_bf16(v0[2], v0[3]); w.z = cvt_pk_bf16(v1[0], v1[1]); w.w = cvt_pk_bf16(v1[2], v1[3]);
                    st16(rowp + bj * HALF, w); } } }
    }
};
__device__ __forceinline__ float silu_f(float v) { return v * __builtin_amdgcn_rcpf(1.f + __expf(-v)); }
struct EpiSwiGLU {
    static constexpr bool PERM = true, AFTER_DRAIN = false, PREFETCH = false, LDSPRE = false; typedef f32x4 acc_t; struct Pre {};
    bf16_t* H; int ldh;
    __device__ __forceinline__ void operator()(const f32x4 (&acc)[2][2][4][2], const Unit& u, int wr, int wc, int fr, int fq) const {
        const int rl0 = wr * 64 + fr, col0 = u.pn * HALF + wc * 32 + 8 * fq;
#pragma unroll
        for (int ai = 0; ai < 2; ++ai)
#pragma unroll
            for (int m = 0; m < 4; ++m) { const int rl = rl0 + ai * HALF + m * 16;
                const f32x4 g0 = acc[ai][0][m][0], g1 = acc[ai][0][m][1], u0 = acc[ai][1][m][0], u1 = acc[ai][1][m][1];
                u32x4 w; w.x = cvt_pk_bf16(silu_f(g0[0]) * u0[0], silu_f(g0[1]) * u0[1]); w.y = cvt_pk_bf16(silu_f(g0[2]) * u0[2], silu_f(g0[3]) * u0[3]);
                w.z = cvt_pk_bf16(silu_f(g1[0]) * u1[0], silu_f(g1[1]) * u1[1]); w.w = cvt_pk_bf16(silu_f(g1[2]) * u1[2], silu_f(g1[3]) * u1[3]);
                if (rl < u.nvalid) st16(H + (size_t)(u.orow + rl) * ldh + col0, w); }
    }
};
struct EpiBf16q {
    static constexpr bool PERM = true, AFTER_DRAIN = false, PREFETCH = false, LDSPRE = true; typedef i32x4 acc_t; struct Pre {}; static constexpr int NST = 16;
    bf16_t* O; int ldc; const float* sa; const float* sb;
    __device__ __forceinline__ void lds_prefetch(PG8_LAS unsigned char* sp, const Unit& u, int wid, int lane) const {
        const int ln = (int)__builtin_amdgcn_mbcnt_hi(~0u, __builtin_amdgcn_mbcnt_lo(~0u, 0u));
        const float* src = (wid < 4 ? sa + u.orow : sb + u.brow - 256) + 64 * wid + ln;
        __builtin_amdgcn_global_load_lds((const unsigned*)src, (PG8_LAS unsigned*)(sp + 256 * wid), 4, 0, 0);
    }
    __device__ __forceinline__ void operator()(const i32x4 (&acc)[2][2][4][2], const Unit& u, int wr, int wc, int fr, int fq, PG8_LAS unsigned char* spb) const {
        const PG8_LAS float* SAl = (const PG8_LAS float*)spb; const PG8_LAS float* SBl = SAl + 256 + wc * 32 + 8 * fq;
        const int row0 = u.orow + wr * 64 + fr, col0 = u.pn * BM + wc * 32 + 8 * fq;
        f32x4 sv[2][2];
#pragma unroll
        for (int bj = 0; bj < 2; ++bj) { sv[bj][0] = *(const PG8_LAS f32x4*)(SBl + bj * HALF); sv[bj][1] = *(const PG8_LAS f32x4*)(SBl + bj * HALF + 4); }
#pragma unroll
        for (int ai = 0; ai < 2; ++ai)
#pragma unroll
            for (int m = 0; m < 4; ++m) { const int row = row0 + ai * HALF + m * 16; const float s = SAl[wr * 64 + fr + ai * HALF + m * 16]; bf16_t* rowp = O + (size_t)row * ldc + col0;
#pragma unroll
                for (int bj = 0; bj < 2; ++bj) { const f32x4 v0 = __builtin_convertvector(acc[ai][bj][m][0], f32x4) * sv[bj][0] * s, v1 = __builtin_convertvector(acc[ai][bj][m][1], f32x4) * sv[bj][1] * s;
                    u32x4 w; w.x = cvt_pk_bf16(v0[0], v0[1]); w.y = cvt_pk_bf16(v0[2], v0[3]); w.z = cvt_pk_bf16(v1[0], v1[1]); w.w = cvt_pk_bf16(v1[2], v1[3]);
                    st16(rowp + bj * HALF, w); } }
    }
};
__device__ __forceinline__ float sgl_f(float gp, float up) { return (gp * up) * __builtin_amdgcn_rcpf(1.f + __builtin_amdgcn_exp2f(gp)); }
template <bool F8OUT> struct EpiSwiGLUqT {
    static constexpr bool PERM = true, AFTER_DRAIN = false, PREFETCH = false, LDSPRE = true; typedef i32x4 acc_t; struct Pre {}; static constexpr int NST = 8;
    bf16_t* H; int ldh; const float* sa; const float* sb; float emu;
    __device__ __forceinline__ void lds_prefetch(PG8_LAS unsigned char* sp, const Unit& u, int wid, int lane) const {
        const int ln = (int)__builtin_amdgcn_mbcnt_hi(~0u, __builtin_amdgcn_mbcnt_lo(~0u, 0u));
        const float* src = (wid < 4 ? sa + u.orow : sb + u.brow - 256) + 64 * wid + ln;
        __builtin_amdgcn_global_load_lds((const unsigned*)src, (PG8_LAS unsigned*)(sp + 256 * wid), 4, 0, 0);
    }
    __device__ __forceinline__ void operator()(const i32x4 (&acc)[2][2][4][2], const Unit& u, int wr, int wc, int fr, int fq, PG8_LAS unsigned char* spb) const {
        const PG8_LAS float* SAl = (const PG8_LAS float*)spb; const PG8_LAS float* SBl = SAl + 256 + wc * 32 + 8 * fq;
        const int rl0 = wr * 64 + fr, col0 = u.pn * HALF + wc * 32 + 8 * fq;
#pragma unroll
        for (int ai = 0; ai < 2; ++ai)
#pragma unroll
            for (int m = 0; m < 4; ++m) { const int rl = rl0 + ai * HALF + m * 16; const float s = SAl[rl];
                const f32x4 sg0 = *(const PG8_LAS f32x4*)SBl, sg1 = *(const PG8_LAS f32x4*)(SBl + 4), su0 = *(const PG8_LAS f32x4*)(SBl + HALF), su1 = *(const PG8_LAS f32x4*)(SBl + HALF + 4);
                const f32x4 g0 = __builtin_convertvector(acc[ai][0][m][0], f32x4) * sg0 * s, g1 = __builtin_convertvector(acc[ai][0][m][1], f32x4) * sg1 * s;
                const f32x4 u0 = __builtin_convertvector(acc[ai][1][m][0], f32x4) * su0 * s, u1 = __builtin_convertvector(acc[ai][1][m][1], f32x4) * su1 * s;
                float r_[8] = {sgl_f(g0[0], u0[0]), sgl_f(g0[1], u0[1]), sgl_f(g0[2], u0[2]), sgl_f(g0[3], u0[3]), sgl_f(g1[0], u1[0]), sgl_f(g1[1], u1[1]), sgl_f(g1[2], u1[2]), sgl_f(g1[3], u1[3])};
                if constexpr (F8OUT) {
                    u32x2 w8; w8.x = pack_fp8x4(r_[0], r_[1], r_[2], r_[3], emu); w8.y = pack_fp8x4(r_[4], r_[5], r_[6], r_[7], emu);
                    if (rl < u.nvalid) *(u32x2*)((signed char*)H + (size_t)(u.orow + rl) * ldh + col0) = w8;
                } else {
                u32x4 w; w.x = cvt_pk_bf16(r_[0], r_[1]); w.y = cvt_pk_bf16(r_[2], r_[3]); w.z = cvt_pk_bf16(r_[4], r_[5]); w.w = cvt_pk_bf16(r_[6], r_[7]);
                if (rl < u.nvalid) st16(H + (size_t)(u.orow + rl) * ldh + col0, w); } }
    }
};
typedef EpiSwiGLUqT<false> EpiSwiGLUq; typedef EpiSwiGLUqT<true> EpiSwiGLUq8;
struct EpiMoeDown {
    static constexpr bool PERM = true, AFTER_DRAIN = false, PREFETCH = false, LDSPRE = false; typedef f32x4 acc_t; struct Pre {};
    bf16_t* x; const float* gate; const int* perm; const float* pw;
    __device__ __forceinline__ void operator()(const f32x4 (&acc)[2][2][4][2], const Unit& u, int wr, int wc, int fr, int fq) const {
        const int rl0 = wr * 64 + fr, col0 = u.pn * BM + wc * 32 + 8 * fq;
        int tokv[2][4]; float pv[2][4];
#pragma unroll
        for (int ai = 0; ai < 2; ++ai)
#pragma unroll
            for (int m = 0; m < 4; ++m) { const int rl = rl0 + ai * HALF + m * 16; const bool ok = rl < u.nvalid; tokv[ai][m] = ok ? perm[u.orow + rl] : 0; pv[ai][m] = ok ? pw[u.orow + rl] : 0.f; }
#pragma unroll
        for (int ai = 0; ai < 2; ++ai) {
            u32x4 xin[4][2];
#pragma unroll
            for (int m = 0; m < 4; ++m)
#pragma unroll
                for (int bj = 0; bj < 2; ++bj) xin[m][bj] = *(const u32x4*)(x + (size_t)tokv[ai][m] * 1024 + col0 + bj * HALF);
#pragma unroll
            for (int m = 0; m < 4; ++m) { const int rl = rl0 + ai * HALF + m * 16;
                if (rl < u.nvalid) { const int tok = tokv[ai][m]; const float p = pv[ai][m];
                    const float* gp = gate + (size_t)(tok >> 13) * 6144 + col0; bf16_t* xp = x + (size_t)tok * 1024 + col0;
#pragma unroll
                    for (int bj = 0; bj < 2; ++bj) { const f32x4 g0 = *(const f32x4*)(gp + bj * HALF), g1 = *(const f32x4*)(gp + bj * HALF + 4); const u32x4 xv = xin[m][bj];
                        const f32x4 v0 = (f32x4){bf_lo(xv.x), bf_hi(xv.x), bf_lo(xv.y), bf_hi(xv.y)} + (g0 * p) * acc[ai][bj][m][0], v1 = (f32x4){bf_lo(xv.z), bf_hi(xv.z), bf_lo(xv.w), bf_hi(xv.w)} + (g1 * p) * acc[ai][bj][m][1];
                        u32x4 w; w.x = cvt_pk_bf16(v0[0], v0[1]); w.y = cvt_pk_bf16(v0[2], v0[3]); w.z = cvt_pk_bf16(v1[0], v1[1]); w.w = cvt_pk_bf16(v1[2], v1[3]);
                        st16(xp + bj * HALF, w); } } } }
    }
};


struct EpiPart {
    static constexpr bool PERM = true, AFTER_DRAIN = false, PREFETCH = false, LDSPRE = false; typedef f32x4 acc_t; struct Pre {};
    float* part;
    __device__ __forceinline__ void operator()(const f32x4 (&acc)[2][2][4][2], const Unit& u, int wr, int wc, int fr, int fq) const {
        float* pt = part + (size_t)u.slice * (BM * BM) + (size_t)(wr * 64 + fr) * BM + wc * 32 + 8 * fq;
#pragma unroll
        for (int ai = 0; ai < 2; ++ai)
#pragma unroll
            for (int m = 0; m < 4; ++m) { float* pr = pt + (size_t)(ai * HALF + m * 16) * BM;
#pragma unroll
                for (int bj = 0; bj < 2; ++bj) { *(f32x4*)(pr + bj * HALF) = acc[ai][bj][m][0]; *(f32x4*)(pr + bj * HALF + 4) = acc[ai][bj][m][1]; } }
    }
};


struct EpiDelta {
    static constexpr bool PERM = true, AFTER_DRAIN = false, PREFETCH = false, LDSPRE = false; typedef f32x4 acc_t; struct Pre {};
    bf16_t* d0; bf16_t* d1; int split; const float* pw; float osc;
    __device__ __forceinline__ void operator()(const f32x4 (&acc)[2][2][4][2], const Unit& u, int wr, int wc, int fr, int fq) const {
        const int rl0 = wr * 64 + fr, col0 = u.pn * BM + wc * 32 + 8 * fq;
        float pv[2][4];
#pragma unroll
        for (int ai = 0; ai < 2; ++ai)
#pragma unroll
            for (int m = 0; m < 4; ++m) pv[ai][m] = pw[u.orow + rl0 + ai * HALF + m * 16] * osc;
#pragma unroll
        for (int ai = 0; ai < 2; ++ai)
#pragma unroll
            for (int m = 0; m < 4; ++m) { const int rl = rl0 + ai * HALF + m * 16, row = u.orow + rl; const float p = pv[ai][m];
                if (rl < u.nvalid) { bf16_t* rowp = (row < split ? d0 + (size_t)row * 1024 : d1 + (size_t)(row - split) * 1024) + col0;
#pragma unroll
                    for (int bj = 0; bj < 2; ++bj) { const f32x4 v0 = acc[ai][bj][m][0] * p, v1 = acc[ai][bj][m][1] * p;
                        u32x4 w; w.x = cvt_pk_bf16(v0[0], v0[1]); w.y = cvt_pk_bf16(v0[2], v0[3]); w.z = cvt_pk_bf16(v1[0], v1[1]); w.w = cvt_pk_bf16(v1[2], v1[3]);
                        st16(rowp + bj * HALF, w); } } }
    }
};

struct EpiDelta8 : EpiDelta { static constexpr bool FP8 = true; };
struct EpiPart8 : EpiPart { static constexpr bool FP8 = true; };
struct EpiRes8 : EpiRes { static constexpr bool FP8 = true; };

template <bool F8> struct EpiResAT {
    static constexpr bool PERM = true, AFTER_DRAIN = false, PREFETCH = false, LDSPRE = false, FP8 = F8; typedef f32x4 acc_t; struct Pre {};
    bf16_t* x; const float* gate; float osc;
    __device__ __forceinline__ void operator()(const f32x4 (&acc)[2][2][4][2], const Unit& u, int wr, int wc, int fr, int fq) const {
        const int row0 = u.orow + wr * 64 + fr, col0 = u.pn * BM + wc * 32 + 8 * fq;
        const float* gp = gate + (size_t)(u.orow >> 13) * 6144 + col0;
        f32x4 gv[2][2];
#pragma unroll
        for (int bj = 0; bj < 2; ++bj)
#pragma unroll
            for (int n = 0; n < 2; ++n) gv[bj][n] = *(const f32x4*)(gp + bj * HALF + 4 * n) * osc;
#pragma unroll
        for (int ai = 0; ai < 2; ++ai)
#pragma unroll
            for (int m = 0; m < 4; ++m) { bf16_t* rowp = x + (size_t)(row0 + ai * HALF + m * 16) * 1024 + col0;
#pragma unroll
                for (int bj = 0; bj < 2; ++bj) { const f32x4 v0 = gv[bj][0] * acc[ai][bj][m][0], v1 = gv[bj][1] * acc[ai][bj][m][1];
                    const unsigned w0 = cvt_pk_bf16(v0[0], v0[1]), w1 = cvt_pk_bf16(v0[2], v0[3]), w2 = cvt_pk_bf16(v1[0], v1[1]), w3 = cvt_pk_bf16(v1[2], v1[3]);
                    bf16_t* p = rowp + bj * HALF;
                    asm volatile("global_atomic_pk_add_bf16 %0, %1, off" :: "v"(p), "v"(w0) : "memory");
                    asm volatile("global_atomic_pk_add_bf16 %0, %1, off offset:4" :: "v"(p), "v"(w1) : "memory");
                    asm volatile("global_atomic_pk_add_bf16 %0, %1, off offset:8" :: "v"(p), "v"(w2) : "memory");
                    asm volatile("global_atomic_pk_add_bf16 %0, %1, off offset:12" :: "v"(p), "v"(w3) : "memory"); } }
    }
};

struct EpiDeltaF8 {
    static constexpr bool PERM = true, AFTER_DRAIN = false, PREFETCH = false, LDSPRE = false, FP8 = true; typedef f32x4 acc_t; struct Pre {};
    signed char* d0; const float* pw; float osc, dsc;
    __device__ __forceinline__ void operator()(const f32x4 (&acc)[2][2][4][2], const Unit& u, int wr, int wc, int fr, int fq) const {
        const int rl0 = wr * 64 + fr, col0 = u.pn * BM + wc * 32 + 8 * fq;
        float pv[2][4];
#pragma unroll
        for (int ai = 0; ai < 2; ++ai)
#pragma unroll
            for (int m = 0; m < 4; ++m) pv[ai][m] = pw[u.orow + rl0 + ai * HALF + m * 16] * osc;
#pragma unroll
        for (int ai = 0; ai < 2; ++ai)
#pragma unroll
            for (int m = 0; m < 4; ++m) { const int rl = rl0 + ai * HALF + m * 16, row = u.orow + rl; const float p = pv[ai][m];
                if (rl < u.nvalid) { signed char* rowp = d0 + (size_t)row * 1024 + col0;
#pragma unroll
                    for (int bj = 0; bj < 2; ++bj) { const f32x4 v0 = acc[ai][bj][m][0] * p, v1 = acc[ai][bj][m][1] * p;
                        u32x2 w; w.x = pack_fp8x4(v0[0], v0[1], v0[2], v0[3], dsc); w.y = pack_fp8x4(v1[0], v1[1], v1[2], v1[3], dsc);
                        *(u32x2*)(rowp + bj * HALF) = w; } } }
    }
};
template <class Epi, class Sched, bool ALIGN_EPI = false, bool SP2 = false>
__device__ __forceinline__ void gemm_phase(PG8_LAS unsigned char* lds, const Gemm g, const Sched& S, const Epi& E, int wv_) {
    int tid_; asm volatile("v_mbcnt_lo_u32_b32 %0, -1, 0\n\tv_mbcnt_hi_u32_b32 %0, -1, %0" : "=v"(tid_)); tid_ += 64 * wv_;
    const int tid = tid_, wid = __builtin_amdgcn_readfirstlane(tid >> 6), lane = tid & 63, wr = wid >> 2, wc = wid & 3, fr = lane & 15, fq = lane >> 4;
    const int K = g.K, ntK = K / BK;
    unsigned voffA[2], voffB[2];
#pragma unroll
    for (int i = 0; i < 2; ++i) { int R, C; stage_rc(tid * 16 + i * 8192, R, C); const int Rb = Epi::PERM ? ((R & ~31) + perm32(R & 31)) : R;
        voffA[i] = (unsigned)(R * K + C) * 2u; voffB[i] = (unsigned)(Rb * K + C) * 2u; }
    const size_t kstep = (size_t)(BK * 2);
    const size_t hstep = (size_t)HALF * K * 2;
    const size_t rstep = (size_t)K * 2;
    const unsigned ldsw = (unsigned)wid * 1024u;
    const int aoff = lds_byte(wr * 64 + fr, fq * 8), boff = lds_byte(wc * 32 + fr, fq * 8);
#define PG8_SA(b, h) (((b) * 2 + (h)) * HTB)
#define PG8_SB(b, h) ((4 + (b) * 2 + (h)) * HTB)
#define PG8_STAGE(bufoff, gbase, voff) do { _Pragma("unroll") for (int _i = 0; _i < 2; ++_i) \
        __builtin_amdgcn_global_load_lds((const unsigned*)((const char*)(gbase) + (voff)[_i]), (PG8_LAS unsigned*)(lds + (bufoff) + ldsw + _i * 8192), 16, 0, 0); } while (0)
#define PG8_LDA(dst, b, h) do { _Pragma("unroll") for (int m = 0; m < 4; ++m) _Pragma("unroll") for (int k = 0; k < 2; ++k) dst[m][k] = *(const PG8_LAS bf16x8*)(lds + PG8_SA(b, h) + aoff + m * 2048 + k * 1024); } while (0)
#define PG8_LDB(dst, b, h) do { _Pragma("unroll") for (int n = 0; n < 2; ++n) _Pragma("unroll") for (int k = 0; k < 2; ++k) dst[n][k] = *(const PG8_LAS bf16x8*)(lds + PG8_SB(b, h) + boff + n * 2048 + k * 1024); } while (0)
#define PG8_MMA(ai, bj, At, Bt) do { __builtin_amdgcn_s_setprio(1); _Pragma("unroll") for (int m = 0; m < 4; ++m) _Pragma("unroll") for (int n = 0; n < 2; ++n) { \
        if constexpr (epi_fp8<Epi>::value) acc[ai][bj][m][n] = mma_f8(Bt[n][0], Bt[n][1], At[m][0], At[m][1], acc[ai][bj][m][n]); \
        else { _Pragma("unroll") for (int k = 0; k < 2; ++k) acc[ai][bj][m][n] = mma_acc(Bt[n][k], At[m][k], acc[ai][bj][m][n]); } } __builtin_amdgcn_s_setprio(0); } while (0)
#define PG8_WAIT_V(n) asm volatile("s_waitcnt vmcnt(" #n ")" ::: "memory")
#define PG8_WAIT_RX(n_) asm volatile("v_readfirstlane_b32 vcc_lo, %0\n\ts_nop 3\n\ts_cmp_eq_u32 vcc_lo, 0\n\ts_cbranch_scc1 2\n\ts_waitcnt vmcnt(" #n_ ")\n\ts_branch 1\n\ts_waitcnt vmcnt(8)" :: "v"(relax_) : "memory", "scc", "vcc")
#define PG8_WAIT_V8R() do { if constexpr (NSTR == 16) PG8_WAIT_RX(24); else if constexpr (NSTR == 8) PG8_WAIT_RX(16); else PG8_WAIT_V(8); } while (0)
#define PG8_WAIT_L(n) asm volatile("s_waitcnt lgkmcnt(" #n ")" ::: "memory")
#define PG8_BAR __builtin_amdgcn_s_barrier()
#define PG8_SCHED __builtin_amdgcn_sched_barrier(0)
    Unit cur, nxt; int ui = 0;
    if (!S.next(0, cur)) return;
    constexpr int NSTR = (SP2 && Sched::FULL) ? epi_nst<Epi>::value : 0;
    typedef typename Epi::acc_t acc_t;
    acc_t acc[2][2][4][2];
    typename Epi::Pre pre;
    { unsigned long long z0_ = 0ull; asm volatile("" : "+v"(z0_));
#pragma unroll
    for (int a = 0; a < 2; ++a)
#pragma unroll
        for (int b = 0; b < 2; ++b)
#pragma unroll
            for (int m = 0; m < 4; ++m)
#pragma unroll
                for (int n = 0; n < 2; ++n) asm volatile("v_mfma_f32_4x4x4_16b_f16 %0, %1, %1, 0" : "=&v"(acc[a][b][m][n]) : "v"(z0_)); }
    bf16x8 At[4][2], B0[2][2], B1[2][2];
    const char* cA = (const char*)g.A + (size_t)cur.arow * rstep + (size_t)cur.kt0 * (BK * 2); const char* cB = (const char*)g.Bt + (size_t)cur.brow * rstep + (size_t)cur.kt0 * (BK * 2);
    int nt = cur.nkt ? cur.nkt : ntK;
    S.a_ready(cur);
    if constexpr (SP2) {
        PG8_STAGE(PG8_SB(0, 0), cB, voffB); PG8_STAGE(PG8_SB(0, 1), cB + hstep, voffB); PG8_STAGE(PG8_SA(0, 0), cA, voffA); PG8_STAGE(PG8_SA(0, 1), cA + hstep, voffA);
        if (wr == 1) PG8_BAR;
        PG8_WAIT_V(2); PG8_BAR;
        PG8_STAGE(PG8_SB(1, 0), cB + kstep, voffB); PG8_STAGE(PG8_SA(1, 0), cA + kstep, voffA); PG8_STAGE(PG8_SB(1, 1), cB + hstep + kstep, voffB);
        PG8_WAIT_V(6); PG8_BAR;
    } else {
        PG8_STAGE(PG8_SB(0, 0), cB, voffB); PG8_STAGE(PG8_SA(0, 0), cA, voffA); PG8_STAGE(PG8_SB(0, 1), cB + hstep, voffB); PG8_STAGE(PG8_SA(0, 1), cA + hstep, voffA);
        if (wr == 1) PG8_BAR;
        PG8_WAIT_V(4); PG8_BAR;
        PG8_STAGE(PG8_SB(1, 0), cB + kstep, voffB); PG8_STAGE(PG8_SA(1, 0), cA + kstep, voffA); PG8_STAGE(PG8_SB(1, 1), cB + hstep + kstep, voffB);
        PG8_WAIT_V(6); PG8_BAR;
    }
    for (;;) {
        const bool has_next = S.next(ui + 1, nxt);
        const char* nA = has_next ? (const char*)g.A + (size_t)nxt.arow * rstep + (size_t)nxt.kt0 * (BK * 2) : cA; const char* nB = has_next ? (const char*)g.Bt + (size_t)nxt.brow * rstep + (size_t)nxt.kt0 * (BK * 2) : cB;
        for (int t = 0; t < nt; t += 2) {
            const bool last = (t == nt - 2);
            const int relax_ = (t == 0 && ui > 0) ? 1 : 0;
            const char* a1 = cA + (size_t)(t + 1) * kstep;
            const char* a2 = last ? nA : cA + (size_t)(t + 2) * kstep; const char* b2 = last ? nB : cB + (size_t)(t + 2) * kstep;
            const char* a3 = a2 + kstep; const char* b3 = b2 + kstep;
            if (last && has_next) S.a_ready(nxt);
            if constexpr (Epi::LDSPRE) { if (last) E.lds_prefetch(lds + PG8_SPARE, cur, wid, lane); }
            if constexpr (Epi::PREFETCH) { if (last) E.prefetch(pre, cur, wr, wc, fr, fq); }
            if constexpr (SP2) {
            PG8_LDB(B0, 0, 0); PG8_LDB(B1, 0, 1); PG8_SCHED; PG8_LDA(At, 0, 0); PG8_STAGE(PG8_SA(1, 1), a1 + hstep, voffA);
            PG8_WAIT_V8R(); PG8_WAIT_L(0); PG8_BAR; PG8_MMA(0, 0, At, B0); PG8_MMA(0, 1, At, B1); PG8_BAR; PG8_SCHED;
            PG8_LDA(At, 0, 1); PG8_STAGE(PG8_SB(0, 0), b2, voffB); PG8_STAGE(PG8_SB(0, 1), b2 + hstep, voffB); PG8_STAGE(PG8_SA(0, 0), a2, voffA);
            PG8_WAIT_V8R(); PG8_WAIT_L(0); PG8_BAR; PG8_MMA(1, 0, At, B0); PG8_MMA(1, 1, At, B1); PG8_BAR; PG8_SCHED;
            PG8_LDB(B0, 1, 0); PG8_LDB(B1, 1, 1); PG8_SCHED; PG8_LDA(At, 1, 0); PG8_STAGE(PG8_SA(0, 1), a2 + hstep, voffA);
            PG8_WAIT_V(8); PG8_WAIT_L(0); PG8_BAR; PG8_MMA(0, 0, At, B0); PG8_MMA(0, 1, At, B1); PG8_BAR; PG8_SCHED;
            PG8_LDA(At, 1, 1); PG8_STAGE(PG8_SB(1, 0), b3, voffB); PG8_STAGE(PG8_SB(1, 1), b3 + hstep, voffB); PG8_STAGE(PG8_SA(1, 0), a3, voffA);
            PG8_WAIT_V(8); PG8_WAIT_L(0); PG8_BAR; PG8_MMA(1, 0, At, B0); PG8_MMA(1, 1, At, B1); PG8_BAR; PG8_SCHED;
            } else {
            PG8_LDB(B0, 0, 0); PG8_SCHED; PG8_LDA(At, 0, 0); PG8_STAGE(PG8_SA(1, 1), a1 + hstep, voffA);
            PG8_WAIT_L(8); PG8_BAR; PG8_WAIT_L(0); PG8_MMA(0, 0, At, B0); PG8_BAR; PG8_SCHED;
            PG8_LDB(B1, 0, 1); PG8_STAGE(PG8_SB(0, 0), b2, voffB);
            PG8_BAR; PG8_WAIT_L(0); PG8_MMA(0, 1, At, B1); PG8_BAR;
            PG8_LDA(At, 0, 1); PG8_STAGE(PG8_SA(0, 0), a2, voffA);
            PG8_BAR; PG8_WAIT_L(0); PG8_MMA(1, 0, At, B0); PG8_BAR; PG8_SCHED;
            PG8_STAGE(PG8_SB(0, 1), b2 + hstep, voffB);
            PG8_WAIT_V(6); PG8_BAR; PG8_MMA(1, 1, At, B1); PG8_BAR;
            PG8_LDB(B0, 1, 0); PG8_SCHED; PG8_LDA(At, 1, 0); PG8_STAGE(PG8_SA(0, 1), a2 + hstep, voffA);
            PG8_WAIT_L(8); PG8_BAR; PG8_WAIT_L(0); PG8_MMA(0, 0, At, B0); PG8_BAR; PG8_SCHED;
            PG8_LDB(B1, 1, 1); PG8_STAGE(PG8_SB(1, 0), b3, voffB);
            PG8_BAR; PG8_WAIT_L(0); PG8_MMA(0, 1, At, B1); PG8_BAR;
            PG8_LDA(At, 1, 1); PG8_STAGE(PG8_SA(1, 0), a3, voffA);
            PG8_BAR; PG8_WAIT_L(0); PG8_MMA(1, 0, At, B0); PG8_BAR; PG8_SCHED;
            PG8_STAGE(PG8_SB(1, 1), b3 + hstep, voffB);
            PG8_WAIT_V(6); PG8_BAR; PG8_MMA(1, 1, At, B1); PG8_BAR;
            }
        }
        if constexpr (epi_fp8<Epi>::value) asm volatile("s_nop 15\n\ts_nop 15" ::: "memory");
        if constexpr (ALIGN_EPI) { if (wr == 0) PG8_BAR; }
        if constexpr (!Epi::AFTER_DRAIN) { if constexpr (Epi::LDSPRE) E(acc, cur, wr, wc, fr, fq, lds + PG8_SPARE); else if constexpr (Epi::PREFETCH) E(acc, cur, wr, wc, fr, fq, pre); else E(acc, cur, wr, wc, fr, fq); S.done(cur); }
        if (!has_next) break;
        { unsigned long long z2_ = 0ull; asm volatile("" : "+v"(z2_));
#pragma unroll
        for (int a = 0; a < 2; ++a)
#pragma unroll
            for (int b = 0; b < 2; ++b)
#pragma unroll
                for (int m = 0; m < 4; ++m)
#pragma unroll
                    for (int n = 0; n < 2; ++n) asm volatile("v_mfma_f32_4x4x4_16b_f16 %0, %1, %1, 0" : "=&v"(acc[a][b][m][n]) : "v"(z2_)); }
        cur = nxt; cA = nA; cB = nB; ++ui; nt = cur.nkt ? cur.nkt : ntK;
        if constexpr (ALIGN_EPI) { if (wr == 1) PG8_BAR; }
    }
    PG8_WAIT_V(0);
    if constexpr (!ALIGN_EPI) { if (wr == 0) PG8_BAR; }
    PG8_BAR;
    if constexpr (Epi::AFTER_DRAIN) { E.fused(acc, cur, wr, wc, fr, fq, lds, wid, lane); S.done(cur); }
#undef PG8_SA
#undef PG8_SB
#undef PG8_STAGE
#undef PG8_LDA
#undef PG8_LDB
#undef PG8_MMA
#undef PG8_WAIT_V
#undef PG8_WAIT_L
#undef PG8_BAR
#undef PG8_SCHED
}
}

#ifndef PG8_SP2
#define PG8_SP2 true
#endif
#ifndef PG8_ALIGN
#define PG8_ALIGN true
#endif
#ifndef MOE_I8
#define MOE_I8 1
#endif
#ifndef IN_I8
#define IN_I8 1
#endif
#ifndef GATHER_OVERLAP
#define GATHER_OVERLAP 1
#endif
#ifndef MOE_TAIL
#define MOE_TAIL 1
#endif
#ifndef MIX_ALT
#define MIX_ALT 1
#endif
#ifndef EPI_STAGGER
#define EPI_STAGGER 0
#endif
#ifndef LOCAL_SEAMS
#define LOCAL_SEAMS 0
#endif
#ifndef FP8_MOE
#define FP8_MOE 1
#endif
#ifndef FP8_DENSE
#define FP8_DENSE 1
#endif
constexpr float F8_HS = 4.f, F8_WS = 4096.f;
#ifndef RES_ALIGN
#define RES_ALIGN true
#endif
#ifndef MK_PER_PHASE
#define MK_PER_PHASE 0
#endif

constexpr int NB = 4, SEQ = 8192, T = NB * SEQ, D = 1024, NZ = 3072, DIN = 3080, FF = 2816, NE = 8, NWAVES = 8;
constexpr float EPS = 1e-6f;
#ifndef RES_ATOMIC
#define RES_ATOMIC 0
#endif
#if RES_ATOMIC
typedef pg8::EpiResAT<false> Gemm2Epi;
#else
typedef pg8::EpiRes Gemm2Epi;
#endif
#if FP8_DENSE
typedef pg8::EpiSwiGLUq8 DenseUpEpi; typedef pg8::EpiRes8 DenseDownEpi;
#else
typedef pg8::EpiSwiGLUq DenseUpEpi; typedef pg8::EpiRes DenseDownEpi;
#endif
#ifndef D_FP8
#define D_FP8 1
#endif
constexpr float F8_DS = 64.f;
#if FP8_MOE
typedef pg8::EpiDelta8 MoeDownEpi; typedef pg8::EpiPart8 MoePartEpi; typedef pg8::EpiSwiGLUq8 MoeUpEpi; constexpr int MOE_DOWN_KT = FF / 128;
#else
typedef pg8::EpiDelta MoeDownEpi; typedef pg8::EpiPart MoePartEpi; typedef pg8::EpiSwiGLUq MoeUpEpi; constexpr int MOE_DOWN_KT = FF / 64;
#endif
constexpr size_t MiB = 1u << 20, KiB = 1u << 10;
constexpr size_t WS_CTL = 0, CTL_ZERO_BYTES = 32 * KiB;
constexpr size_t WS_MOD = 1 * MiB, WS_WG8 = 1 * MiB + 256 * KiB, WS_WR8 = 1 * MiB + 384 * KiB;
constexpr size_t WS_G = 2 * MiB, WS_RL = 3 * MiB, WS_TOPI = 4 * MiB, WS_TOPP = 4 * MiB + 256 * KiB, WS_PERM = 4 * MiB + 512 * KiB, WS_PW = 4 * MiB + 768 * KiB;
constexpr size_t WS_CNT = 5 * MiB, WS_TILES = 5 * MiB + 64 * KiB, WS_NT = 5 * MiB + 128 * KiB, WS_CAR = 6 * MiB, WS_HIN = 7 * MiB;
constexpr size_t WS_WIN = 8 * MiB, WS_WOUT = 20 * MiB, WS_WF1 = 24 * MiB, WS_WF2 = 35 * MiB, WS_WE1 = 41 * MiB, WS_WE2 = 129 * MiB;
constexpr size_t WS_HB = 174 * MiB, WS_Z = 238 * MiB, WS_HRAW = 430 * MiB, WS_END = 512 * MiB;
constexpr int D0_SPLIT = 16896;
constexpr size_t WS_D0A = 8 * MiB, WS_D0B = WS_HRAW, WS_D1 = 41 * MiB, WS_PART = WS_HRAW + (size_t)(T + 256) * D;
constexpr int PART_SLOTS = (int)((WS_END - WS_PART) / (256 * 256 * 4));
static_assert((size_t)D0_SPLIT * D * 2 <= 33 * MiB && (size_t)(T - D0_SPLIT) * D * 2 <= (size_t)(T + 256) * D && WS_D1 + (size_t)T * D * 2 <= 129 * MiB, "deferred-residual map");
constexpr int MAXTILES = 160;
static_assert(WS_WE2 + (size_t)NE * D * FF * 2 <= WS_HB && WS_Z + (size_t)(T + 256) * FF * 2 <= WS_HRAW && WS_HRAW + (size_t)(T + 256) * D * 2 <= WS_END, "d_ws map");
constexpr int CW_TMO = 0, CW_BAR = 4096;
constexpr int RING_OFF = 0, RING_BYTES = 131072;
constexpr int LDSCTL_OFF = RING_BYTES, MISC_OFF = LDSCTL_OFF + 320;
constexpr int LDS_BYTES = 147456;

#define GAS __attribute__((address_space(1)))
#define LAS __attribute__((address_space(3)))
typedef unsigned short bf16;
typedef unsigned v4u __attribute__((ext_vector_type(4)));
typedef unsigned v2u __attribute__((ext_vector_type(2)));
typedef float f32x4 __attribute__((ext_vector_type(4)));
typedef float f32x2 __attribute__((ext_vector_type(2)));
typedef GAS unsigned gu32;
#define RLX_AGENT __ATOMIC_RELAXED, __HIP_MEMORY_SCOPE_AGENT
#define LDS_WAIT() asm volatile("s_waitcnt lgkmcnt(0)" ::: "memory")
#define VM_WAIT() asm volatile("s_waitcnt vmcnt(0)" ::: "memory")
__device__ __forceinline__ unsigned f2bf(float f) { unsigned u = __builtin_bit_cast(unsigned, f); return (u + 0x7fffu + ((u >> 16) & 1u)) >> 16; }
__device__ __forceinline__ f32x4 fp8x4_f(unsigned w) { return (f32x4){__builtin_amdgcn_cvt_f32_fp8((int)w, 0), __builtin_amdgcn_cvt_f32_fp8((int)w, 1), __builtin_amdgcn_cvt_f32_fp8((int)w, 2), __builtin_amdgcn_cvt_f32_fp8((int)w, 3)}; }
__device__ __forceinline__ f32x4 zero4() { f32x4 z; asm volatile("v_mov_b32 %0, 0" : "=v"(z.x)); asm volatile("v_mov_b32 %0, 0" : "=v"(z.y)); asm volatile("v_mov_b32 %0, 0" : "=v"(z.z)); asm volatile("v_mov_b32 %0, 0" : "=v"(z.w)); return z; }
__device__ __forceinline__ unsigned pk2(float lo, float hi) { unsigned r; asm("v_cvt_pk_bf16_f32 %0, %1, %2" : "=v"(r) : "v"(lo), "v"(hi)); return r; }
__device__ __forceinline__ float bf2f(unsigned v) { return __builtin_bit_cast(float, v << 16); }
__device__ __forceinline__ float bflo(unsigned w) { return __builtin_bit_cast(float, w << 16); }
__device__ __forceinline__ float bfhi(unsigned w) { return __builtin_bit_cast(float, w & 0xffff0000u); }
__device__ __forceinline__ float sigmoid_f(float v) { return __builtin_amdgcn_rcpf(1.f + __builtin_amdgcn_exp2f(-1.4426950408889634f * v)); }
__device__ __forceinline__ float silu_acc(float v) { return v * __builtin_amdgcn_rcpf(1.f + __builtin_amdgcn_exp2f(-1.4426950408889634f * v)); }
__device__ __forceinline__ float logsigmoid_f(float v) { return fminf(v, 0.f) - log1pf(__expf(-fabsf(v))); }
__device__ __forceinline__ float softplus_f(float v) { return fmaxf(v, 0.f) + log1pf(__expf(-fabsf(v))); }
__device__ __forceinline__ float gelu_tanh_f(float v) { return v * __builtin_amdgcn_rcpf(1.f + __builtin_amdgcn_exp2f(v * fmaf(v * v, -0.10294324f, -2.3022082f))); }

#define XB_TMO      128
#define XB_XCNT(j)  (256  + 64 * (j))
#define XB_XSUB(j)  (1280 + 64 * (j))
#define XB_XGEN(j)  (2304 + 64 * (j))
#define XB_TOP      3328
#define XB_TOPGEN   3392
#define XCD_BAR_WORDS 3456
#define XB_SPIN_CAP (1u << 18)

__device__ __forceinline__ unsigned xb_ld(unsigned* p)              { return __hip_atomic_load(p, __ATOMIC_RELAXED, __HIP_MEMORY_SCOPE_AGENT); }
__device__ __forceinline__ unsigned xb_add(unsigned* p, unsigned v) { return __hip_atomic_fetch_add(p, v, __ATOMIC_RELAXED, __HIP_MEMORY_SCOPE_AGENT); }
__device__ __forceinline__ unsigned xb_xcc_id() { return (unsigned)__builtin_amdgcn_s_getreg((3 << 11) | 20) & 0xFu; }
#define XB_SPIN(cond, bar) do { unsigned _sp = 0; while (cond) { __builtin_amdgcn_s_sleep(1); \
    if ((++_sp & 255u) == 0u) { if (xb_ld(&(bar)[XB_TMO])) break; if (_sp > XB_SPIN_CAP) { atomicAdd(&(bar)[XB_TMO], 1u); break; } } } } while (0)

struct XcdBarrier {
    unsigned* bar; unsigned x;
    unsigned lead;
    volatile LAS unsigned* st;
};

__device__ __forceinline__ XcdBarrier xcd_barrier_post(unsigned* bar, volatile LAS unsigned* st) {
    XcdBarrier b; b.bar = bar; b.x = xb_xcc_id(); b.st = st; b.lead = __builtin_amdgcn_readfirstlane(threadIdx.x >> 6) == 0 ? 1u : 0u;
    if (threadIdx.x == 0) (void)xb_add(&bar[XB_XCNT(b.x)], 1u);
    return b;
}
__device__ __forceinline__ void xcd_barrier_complete(unsigned* bar, unsigned x, unsigned& nloc, unsigned& nx) {
    const unsigned G = gridDim.x * gridDim.y * gridDim.z;
    unsigned sum, cnt, mine, sp = 0u;
    for (;;) {
        sum = 0u; cnt = 0u; mine = 0u;
#pragma unroll
        for (unsigned j = 0; j < 16; ++j) { const unsigned c = xb_ld(&bar[XB_XCNT(j)]); sum += c; cnt += (c > 0u) ? 1u : 0u; mine = (j == x) ? c : mine; }
        if (sum == G) break;
        __builtin_amdgcn_s_sleep(1);
        if ((++sp & 255u) == 0u) { if (xb_ld(&bar[XB_TMO])) break; if (sp > XB_SPIN_CAP) { atomicAdd(&bar[XB_TMO], 1u); break; } }
    }
    nloc = mine > 0u ? mine : 1u; nx = cnt > 0u ? cnt : 1u;
}

__device__ __forceinline__ void xcd_barrier(const XcdBarrier& b) {
    asm volatile("s_waitcnt vmcnt(0)" ::: "memory");
    __syncthreads();
    int l0_; asm volatile("v_mbcnt_lo_u32_b32 %0, -1, 0\n\tv_mbcnt_hi_u32_b32 %0, -1, %0" : "=v"(l0_));
    if (b.lead && l0_ == 0) {
        unsigned* bar = b.bar;
        __builtin_amdgcn_s_waitcnt(0);
        unsigned nloc = b.st[0], nx = b.st[1];
        if (nloc == 0u) { xcd_barrier_complete(bar, b.x, nloc, nx); b.st[0] = nloc; b.st[1] = nx; }
        const unsigned old = xb_add(&bar[XB_XSUB(b.x)], 1u);
        const unsigned gen = old / nloc;
        if (old + 1u == (gen + 1u) * nloc) {
            __builtin_amdgcn_fence(__ATOMIC_RELEASE, "agent");
            asm volatile("s_waitcnt vmcnt(0)" ::: "memory");
            const unsigned og = xb_add(&bar[XB_TOP], 1u);
            const unsigned tg = og / nx;
            if (og + 1u == (tg + 1u) * nx) xb_add(&bar[XB_TOPGEN], 1u);
            else XB_SPIN(xb_ld(&bar[XB_TOPGEN]) == tg, bar);
            __builtin_amdgcn_fence(__ATOMIC_ACQUIRE, "agent");
            xb_add(&bar[XB_XGEN(b.x)], 1u);
            asm volatile("s_waitcnt vmcnt(0)" ::: "memory");
        } else {
            XB_SPIN(xb_ld(&bar[XB_XGEN(b.x)]) == gen, bar);
            __builtin_amdgcn_fence(__ATOMIC_ACQUIRE, "agent");
            asm volatile("s_waitcnt vmcnt(0)" ::: "memory");
        }
    }
    __syncthreads();
}
#define GB_CNT(g)  (XCD_BAR_WORDS + 64 * (1 + (g)))
__device__ __forceinline__ void grp_barrier_post(unsigned* bar, unsigned g, unsigned x) { __hip_atomic_fetch_or(&bar[GB_CNT(g) + 1], 1u << x, __ATOMIC_RELAXED, __HIP_MEMORY_SCOPE_AGENT); }
__device__ __forceinline__ void grp_barrier(const XcdBarrier& b, unsigned g, unsigned tgt, volatile LAS unsigned* st2) {
    asm volatile("s_waitcnt vmcnt(0)" ::: "memory");
    __syncthreads();
    int l0_; asm volatile("v_mbcnt_lo_u32_b32 %0, -1, 0\n\tv_mbcnt_hi_u32_b32 %0, -1, %0" : "=v"(l0_));
    if (b.lead && l0_ == 0) {
        unsigned* bar = b.bar;
        __builtin_amdgcn_s_waitcnt(0);
        unsigned mode = st2[0];
        if (mode == 0u) { const unsigned m = xb_ld(&bar[GB_CNT(g) + 1]); mode = (m != 0u && (m & (m - 1u)) == 0u) ? 1u : 2u; st2[0] = mode; }
        if (mode != 1u) { __builtin_amdgcn_fence(__ATOMIC_RELEASE, "agent"); asm volatile("s_waitcnt vmcnt(0)" ::: "memory"); }
        (void)xb_add(&bar[GB_CNT(g)], 1u);
        XB_SPIN(xb_ld(&bar[GB_CNT(g)]) < tgt, bar);
        __builtin_amdgcn_fence(__ATOMIC_ACQUIRE, "agent");
        asm volatile("s_waitcnt vmcnt(0)" ::: "memory");
    }
    __syncthreads();
}

struct Frame {
    LAS unsigned char* lds;
    volatile LAS unsigned* MISC;
    gu32* ctl;
    int tid, lane, wave;
    int vcu, G;
    const float *x, *c, *w_ada, *b_ada, *g_norm_mix, *g_norm_ffn, *w_in, *w_conv_qk, *b_conv_qk, *b_gates, *w_conv_lru, *b_conv_lru, *w_lru_a, *b_lru_a, *w_lru_x, *b_lru_x, *lru_lambda, *g_mix_out, *w_out;
    const float *w_ff_gate, *w_ff_up, *w_ff_down, *w_router, *b_router, *w_exp_gate, *w_exp_up, *w_exp_down, *g_final;
    float* out;
    float *MOD, *WG8, *WR8, *G8, *RL, *TOPP, *PW, *CAR, *HIN, *HRAW, *CLOC, *MST, *SA, *SAS, *SBF1, *SBE1, *SBIN, *SBINX;
    int *TOPI, *PERM, *CNT, *TILES, *NT, *POS1, *POS0; bf16 *D0A, *D0B, *D1, *HB8F, *HB8R; float* PART;
    bf16 *WIN, *WOUT, *WF1, *WF2, *WE1, *WE2, *HB, *Z, *HID, *ASORT, *XB;
};

template <int CTRL, int RM, int BM> __device__ __forceinline__ float dpp_f(float old, float v) {
    return __builtin_bit_cast(float, __builtin_amdgcn_update_dpp(__builtin_bit_cast(int, old), __builtin_bit_cast(int, v), CTRL, RM, BM, false)); }
__device__ __forceinline__ float wave_sum(float v) {
#pragma unroll
    for (int o = 1; o < 64; o <<= 1) v += __shfl_xor(v, o);
    return v;
}
__device__ __forceinline__ float wave_sum_dpp(float v) {
    v += dpp_f<0xB1, 0xf, 0xf>(0.f, v); v += dpp_f<0x4E, 0xf, 0xf>(0.f, v); v += dpp_f<0x124, 0xf, 0xf>(0.f, v); v += dpp_f<0x128, 0xf, 0xf>(0.f, v);
    v += dpp_f<0x142, 0xa, 0xf>(0.f, v);
    v += dpp_f<0x143, 0xc, 0xf>(0.f, v);
    return __builtin_bit_cast(float, __builtin_amdgcn_readlane(__builtin_bit_cast(int, v), 63));
}
__device__ __forceinline__ float wave_max(float v) {
    v = fmaxf(v, dpp_f<0xB1, 0xf, 0xf>(v, v)); v = fmaxf(v, dpp_f<0x4E, 0xf, 0xf>(v, v)); v = fmaxf(v, dpp_f<0x124, 0xf, 0xf>(v, v)); v = fmaxf(v, dpp_f<0x128, 0xf, 0xf>(v, v));
    v = fmaxf(v, dpp_f<0x142, 0xa, 0xf>(v, v)); v = fmaxf(v, dpp_f<0x143, 0xc, 0xf>(v, v));
    return __builtin_bit_cast(float, __builtin_amdgcn_readlane(__builtin_bit_cast(int, v), 63));
}

#define R4_STEP(OP, CTRL) asm volatile(OP " %0, %0, %0 " CTRL "\n\t" OP " %1, %1, %1 " CTRL "\n\t" OP " %2, %2, %2 " CTRL "\n\t" OP " %3, %3, %3 " CTRL : "+v"(a), "+v"(b), "+v"(c), "+v"(d))
__device__ __forceinline__ void wave_sum4(float& a, float& b, float& c, float& d) {
    asm volatile("s_nop 1" : "+v"(a), "+v"(b), "+v"(c), "+v"(d));
    R4_STEP("v_add_f32_dpp", "quad_perm:[1,0,3,2] row_mask:0xf bank_mask:0xf"); R4_STEP("v_add_f32_dpp", "quad_perm:[2,3,0,1] row_mask:0xf bank_mask:0xf");
    R4_STEP("v_add_f32_dpp", "row_ror:4 row_mask:0xf bank_mask:0xf"); R4_STEP("v_add_f32_dpp", "row_ror:8 row_mask:0xf bank_mask:0xf");
    R4_STEP("v_add_f32_dpp", "row_bcast:15 row_mask:0xa bank_mask:0xf"); R4_STEP("v_add_f32_dpp", "row_bcast:31 row_mask:0xc bank_mask:0xf");
    a = __builtin_bit_cast(float, __builtin_amdgcn_readlane(__builtin_bit_cast(int, a), 63)); b = __builtin_bit_cast(float, __builtin_amdgcn_readlane(__builtin_bit_cast(int, b), 63));
    c = __builtin_bit_cast(float, __builtin_amdgcn_readlane(__builtin_bit_cast(int, c), 63)); d = __builtin_bit_cast(float, __builtin_amdgcn_readlane(__builtin_bit_cast(int, d), 63));
}
__device__ __forceinline__ void wave_max4(float& a, float& b, float& c, float& d) {
    asm volatile("s_nop 1" : "+v"(a), "+v"(b), "+v"(c), "+v"(d));
    R4_STEP("v_max_f32_dpp", "quad_perm:[1,0,3,2] row_mask:0xf bank_mask:0xf"); R4_STEP("v_max_f32_dpp", "quad_perm:[2,3,0,1] row_mask:0xf bank_mask:0xf");
    R4_STEP("v_max_f32_dpp", "row_ror:4 row_mask:0xf bank_mask:0xf"); R4_STEP("v_max_f32_dpp", "row_ror:8 row_mask:0xf bank_mask:0xf");
    R4_STEP("v_max_f32_dpp", "row_bcast:15 row_mask:0xa bank_mask:0xf"); R4_STEP("v_max_f32_dpp", "row_bcast:31 row_mask:0xc bank_mask:0xf");
    a = __builtin_bit_cast(float, __builtin_amdgcn_readlane(__builtin_bit_cast(int, a), 63)); b = __builtin_bit_cast(float, __builtin_amdgcn_readlane(__builtin_bit_cast(int, b), 63));
    c = __builtin_bit_cast(float, __builtin_amdgcn_readlane(__builtin_bit_cast(int, c), 63)); d = __builtin_bit_cast(float, __builtin_amdgcn_readlane(__builtin_bit_cast(int, d), 63));
}
template <int X> __device__ __forceinline__ float lane_xor(float v) {
    if constexpr (X == 1) return dpp_f<0xB1, 0xf, 0xf>(v, v);
    else if constexpr (X == 2) return dpp_f<0x4E, 0xf, 0xf>(v, v);
    else if constexpr (X == 4) { const float r = dpp_f<0x104, 0xf, 0x5>(v, v); return dpp_f<0x114, 0xf, 0xa>(r, v); }
    else if constexpr (X == 8) { const float r = dpp_f<0x108, 0xf, 0x3>(v, v); return dpp_f<0x118, 0xf, 0xc>(r, v); }
    else return __shfl_xor(v, X);
}

struct TrD { const float* W; bf16* WT; int ldw, K, k0, n0, q8; };
constexpr int NTRITEMS = 2 * 512 + 1408 + NE * 1408;
__device__ __forceinline__ TrD tr_desc(Frame& F, int it) {
    TrD d; int r;
    d.q8 = ((FP8_MOE && it >= 2432) || (FP8_DENSE && it >= 1024 && it < 2432)) ? 1 : 0;
    if (it < 1024) { const int l = it >> 9; r = it & 511; d.W = F.w_out + (size_t)l * D * D; d.WT = F.WOUT + (size_t)l * D * D; d.K = D; }
    else if (it < 2432) { r = it - 1024; d.W = F.w_ff_down; d.WT = F.WF2; d.K = FF; }
    else { const int e = (it - 2432) / 1408; r = (it - 2432) % 1408; d.W = F.w_exp_down + (size_t)e * FF * D; d.WT = FP8_MOE ? (bf16*)((signed char*)F.WE2 + (size_t)e * D * FF) : F.WE2 + (size_t)e * D * FF; d.K = FF; }
    d.ldw = D; d.k0 = 64 * (r >> 5); d.n0 = 32 * (r & 31); return d;
}
__device__ __forceinline__ void tr_load(float (&wv)[32], const TrD& d, int lane) {
#pragma unroll
    for (int i = 0; i < 32; ++i) wv[i] = d.W[(size_t)(d.k0 + 2 * i + (lane >> 5)) * d.ldw + d.n0 + (lane & 31)];
}
__device__ __forceinline__ void tr_store(const float (&wv)[32], const TrD& d, LAS float* scr, int lane) {
#pragma unroll
    for (int i = 0; i < 32; ++i) scr[(2 * i + (lane >> 5)) * 33 + (lane & 31)] = wv[i];
    LDS_WAIT(); asm volatile("" ::: "memory");
    const int c = lane & 7;
#pragma unroll
    for (int j = 0; j < 4; ++j) { const int n = (lane >> 3) + 8 * j; const LAS float* s = scr + (8 * c) * 33 + n;
        if (d.q8) { v2u o8; o8.x = pg8::pack_fp8x4(s[0 * 33], s[1 * 33], s[2 * 33], s[3 * 33], F8_WS); o8.y = pg8::pack_fp8x4(s[4 * 33], s[5 * 33], s[6 * 33], s[7 * 33], F8_WS);
            *(GAS v2u*)((signed char*)d.WT + (size_t)(d.n0 + n) * d.K + d.k0 + 8 * c) = o8; }
        else {
        v4u o; o.x = pk2(s[0 * 33], s[1 * 33]); o.y = pk2(s[2 * 33], s[3 * 33]); o.z = pk2(s[4 * 33], s[5 * 33]); o.w = pk2(s[6 * 33], s[7 * 33]);
        *(GAS v4u*)(d.WT + (size_t)(d.n0 + n) * d.K + d.k0 + 8 * c) = o; } }
    LDS_WAIT(); asm volatile("" ::: "memory");
}

__device__ __forceinline__ void p0_prologue(Frame& F) {
    {
        LAS float* red = (LAS float*)(F.lds + RING_OFF);
        for (int u = blockIdx.x; u < 192; u += F.G) {
            const int l = u / 96, cb = u % 96, cg = F.lane & 15, ks = F.lane >> 4;
            const float* W = F.w_ada + (size_t)l * D * 6144 + cb * 64 + 4 * cg;
            const int kb = F.wave * 128;
            f32x4 a0 = zero4(), a1 = a0, a2 = a0, a3 = a0;
            for (int h2 = 0; h2 < 2; ++h2) {
                f32x4 wv[16];
#pragma unroll
                for (int i = 0; i < 16; ++i) wv[i] = *(const f32x4*)(W + (size_t)(kb + 64 * h2 + 4 * i + ks) * 6144);
#pragma unroll
                for (int i = 0; i < 16; ++i) { const int kk = kb + 64 * h2 + 4 * i + ks;
                    a0 += wv[i] * silu_acc(F.c[kk]); a1 += wv[i] * silu_acc(F.c[D + kk]); a2 += wv[i] * silu_acc(F.c[2 * D + kk]); a3 += wv[i] * silu_acc(F.c[3 * D + kk]); }
            }
#pragma unroll
            for (int o = 16; o < 64; o <<= 1) {
#pragma unroll
                for (int e = 0; e < 4; ++e) { a0[e] += __shfl_xor(a0[e], o); a1[e] += __shfl_xor(a1[e], o); a2[e] += __shfl_xor(a2[e], o); a3[e] += __shfl_xor(a3[e], o); } }
            if (ks == 0) { *(LAS f32x4*)(red + (F.wave * 4 + 0) * 64 + 4 * cg) = a0; *(LAS f32x4*)(red + (F.wave * 4 + 1) * 64 + 4 * cg) = a1; *(LAS f32x4*)(red + (F.wave * 4 + 2) * 64 + 4 * cg) = a2; *(LAS f32x4*)(red + (F.wave * 4 + 3) * 64 + 4 * cg) = a3; }
            __syncthreads();
            if (F.tid < 256) { const int b = F.tid >> 6, cl = F.tid & 63; float s = F.b_ada[l * 6144 + cb * 64 + cl];
#pragma unroll
                for (int w = 0; w < 8; ++w) s += red[(w * 4 + b) * 64 + cl];
                F.MOD[(l * 4 + b) * 6144 + cb * 64 + cl] = s; }
            __syncthreads();
        }
    }
    {
        const int gt = blockIdx.x * (NWAVES * 64) + F.tid, NT_ = F.G * NWAVES * 64;
        for (int i = gt; i < 2 * 8 * D; i += NT_) { const int l = i >> 13, j = (i >> 10) & 7, k = i & 1023; F.WG8[i] = F.w_in[(size_t)l * D * DIN + (size_t)k * DIN + 2048 + j]; }
        for (int i = gt; i < 8 * D; i += NT_) { const int j = i >> 10, k = i & 1023; F.WR8[i] = F.w_router[k * 8 + j]; }
    }
    static_assert(IN_I8 && MOE_I8, "the bf16 copies of w_in and of the gate/up projections are not built any more");
    __syncthreads();
    LAS float* scr = (LAS float*)(F.lds + RING_OFF + F.wave * 16384);
    const int gw = F.vcu * NWAVES + F.wave, NGW = F.G * NWAVES;
    float wa[32], wb[32];
    int it = gw;
    if (it < NTRITEMS) tr_load(wa, tr_desc(F, it), F.lane);
    while (it < NTRITEMS) {
        if (it + NGW < NTRITEMS) tr_load(wb, tr_desc(F, it + NGW), F.lane);
        tr_store(wa, tr_desc(F, it), scr, F.lane);
        it += NGW; if (it >= NTRITEMS) break;
        if (it + NGW < NTRITEMS) tr_load(wa, tr_desc(F, it + NGW), F.lane);
        tr_store(wb, tr_desc(F, it), scr, F.lane);
        it += NGW;
    }
    __syncthreads();
}
struct StripD { const float* W; int ldw, ns0, nd0; signed char* WQ; float* SB; float sfac; };
constexpr int NSTRIP_FF = (MOE_I8 ? 9 : 1) * 176, NSTRIP = NSTRIP_FF + (IN_I8 ? 2 * 96 : 0);
__device__ __forceinline__ StripD strip_desc(Frame& F, int s) {
    StripD d;
    if (s < NSTRIP_FF) { const int m = s / 176, r = s % 176, up = r / 88, nb = r % 88; d.ns0 = 32 * nb; d.sfac = up ? -0.6931471805599453f : -1.4426950408889634f; d.nd0 = (d.ns0 >> 7) * 256 + 128 * up + (d.ns0 & 127); d.ldw = FF;
        d.W = m == 0 ? (up ? F.w_ff_up : F.w_ff_gate) : (up ? F.w_exp_up : F.w_exp_gate) + (size_t)(m - 1) * D * FF;
        d.WQ = m == 0 ? (signed char*)F.WF1 : (signed char*)F.WE1 + (size_t)(m - 1) * 2 * FF * D; d.SB = m == 0 ? F.SBF1 : F.SBE1 + (m - 1) * 2 * FF; }
    else { const int t = s - NSTRIP_FF, l = t / 96, nb = t % 96; d.sfac = 1.f; d.ns0 = nb < 64 ? 32 * nb : 2056 + 32 * (nb - 64); d.nd0 = nb < 64 ? 32 * nb : 2048 + 32 * (nb - 64); d.ldw = DIN;
        d.W = F.w_in + (size_t)l * D * DIN; d.WQ = (signed char*)F.WIN + (size_t)l * NZ * D; d.SB = F.SBIN + l * NZ; }
    return d;
}
__device__ __forceinline__ void strip_load(float (&v)[64], const StripD& d, int wave, int lane) {
    const int n = lane & 31, k0 = 128 * wave + 64 * (lane >> 5);
#pragma unroll
    for (int i = 0; i < 64; ++i) v[i] = d.W[(size_t)(k0 + i) * d.ldw + d.ns0 + n];
}
__device__ __forceinline__ void strip_quant(const float (&v)[64], const StripD& d, LAS float* smax, int wave, int lane) {
    const int n = lane & 31, kh = lane >> 5, k0 = 128 * wave + 64 * kh;
    float m = 0.f;
#pragma unroll
    for (int i = 0; i < 64; ++i) m = fmaxf(m, fabsf(v[i]));
    m = fmaxf(m, __shfl_xor(m, 32));
    if (lane < 32) smax[wave * 32 + n] = m;
    __syncthreads();
    float mm = 0.f;
#pragma unroll
    for (int w = 0; w < 8; ++w) mm = fmaxf(mm, smax[w * 32 + n]);
    const float inv = mm > 0.f ? 127.f / mm : 0.f;
    signed char* dst = d.WQ + (size_t)(d.nd0 + n) * 1024 + k0;
#pragma unroll
    for (int c = 0; c < 4; ++c) { v4u o; unsigned* op = (unsigned*)&o;
#pragma unroll
        for (int q = 0; q < 4; ++q) { const int i = 16 * c + 4 * q;
            const int q0 = __float2int_rn(v[i] * inv), q1 = __float2int_rn(v[i + 1] * inv), q2 = __float2int_rn(v[i + 2] * inv), q3 = __float2int_rn(v[i + 3] * inv);
            op[q] = (unsigned)(q0 & 255) | ((unsigned)(q1 & 255) << 8) | ((unsigned)(q2 & 255) << 16) | ((unsigned)q3 << 24); }
        *(GAS v4u*)(dst + 16 * c) = o; }
    if (wave == 0 && kh == 0) d.SB[d.nd0 + n] = mm * (1.f / 127.f) * d.sfac;
}
__device__ __forceinline__ void quant_weights(Frame& F) {
    LAS float* smax = (LAS float*)(F.lds + RING_OFF);
    __syncthreads();
    float va[64], vb[64];
    int s = blockIdx.x;
    if (s < NSTRIP) strip_load(va, strip_desc(F, s), F.wave, F.lane);
    while (s < NSTRIP) {
        if (s + F.G < NSTRIP) strip_load(vb, strip_desc(F, s + F.G), F.wave, F.lane);
        strip_quant(va, strip_desc(F, s), smax, F.wave, F.lane);
        s += F.G; if (s >= NSTRIP) break;
        if (s + F.G < NSTRIP) strip_load(va, strip_desc(F, s + F.G), F.wave, F.lane);
        strip_quant(vb, strip_desc(F, s), smax + 256, F.wave, F.lane);
        s += F.G;
    }
    __syncthreads();
}

#define BFLY_STEP(N_, X_) do { _Pragma("unroll") for (int i_ = 0; i_ < (N_) / 2; ++i_) { const bool up_ = (lane & (X_)) != 0; const float send_ = up_ ? p[2 * i_] : p[2 * i_ + 1], keep_ = up_ ? p[2 * i_ + 1] : p[2 * i_]; p[i_] = keep_ + lane_xor<(X_)>(send_); } } while (0)
template <bool XF32>
__device__ __forceinline__ void norm_load(f32x4 (&v)[4][4], const void* xin, size_t row, int lane) {
#pragma unroll
    for (int r = 0; r < 4; ++r)
#pragma unroll
        for (int j = 0; j < 2; ++j) {
            if (XF32) { const GAS f32x4* p = (const GAS f32x4*)((const float*)xin + (row + r) * D + 8 * lane + 512 * j); v[r][2 * j] = p[0]; v[r][2 * j + 1] = p[1]; }
            else { const v4u x = *(const GAS v4u*)((const bf16*)xin + (row + r) * D + 8 * lane + 512 * j);
                v[r][2 * j] = (f32x4){bflo(x.x), bfhi(x.x), bflo(x.y), bfhi(x.y)}; v[r][2 * j + 1] = (f32x4){bflo(x.z), bfhi(x.z), bflo(x.w), bfhi(x.w)}; } }
}
template <bool SMALL, bool QOUT>
__device__ __forceinline__ void norm_batch(f32x4 (&v)[4][4], const f32x4 (&gs)[4], const f32x4 (&shv)[4], bf16* Hrow0, const LAS float* wl, const float* bsm, float* Srow0, int lane, float* SArow0) {
    float s[4];
#pragma unroll
    for (int r = 0; r < 4; ++r) { s[r] = 0.f;
#pragma unroll
        for (int j = 0; j < 4; ++j) s[r] += (v[r][j].x * v[r][j].x + v[r][j].y * v[r][j].y) + (v[r][j].z * v[r][j].z + v[r][j].w * v[r][j].w); }
    wave_sum4(s[0], s[1], s[2], s[3]);
#pragma unroll
    for (int r = 0; r < 4; ++r) { const float rstd = __builtin_amdgcn_rsqf(s[r] * (1.f / D) + EPS);
#pragma unroll
        for (int j = 0; j < 4; ++j) v[r][j] = v[r][j] * rstd * gs[j] + shv[j];
        if (!QOUT) {
#pragma unroll
        for (int j = 0; j < 2; ++j) { v4u o; o.x = pk2(v[r][2 * j].x, v[r][2 * j].y); o.y = pk2(v[r][2 * j].z, v[r][2 * j].w); o.z = pk2(v[r][2 * j + 1].x, v[r][2 * j + 1].y); o.w = pk2(v[r][2 * j + 1].z, v[r][2 * j + 1].w);
            *(GAS v4u*)(Hrow0 + (size_t)r * D + 8 * lane + 512 * j) = o; } } }
    if (QOUT) {
        float mx[4];
#pragma unroll
        for (int r = 0; r < 4; ++r) { mx[r] = 0.f;
#pragma unroll
            for (int j = 0; j < 4; ++j) mx[r] = fmaxf(fmaxf(mx[r], fmaxf(fabsf(v[r][j].x), fabsf(v[r][j].y))), fmaxf(fabsf(v[r][j].z), fabsf(v[r][j].w))); }
        wave_max4(mx[0], mx[1], mx[2], mx[3]);
#pragma unroll
        for (int r = 0; r < 4; ++r) { const float inv = mx[r] > 0.f ? 127.f / mx[r] : 0.f;
            signed char* hq = (signed char*)Hrow0 + (size_t)r * D;
#pragma unroll
            for (int j = 0; j < 2; ++j) { const f32x4 a = v[r][2 * j] * inv, c = v[r][2 * j + 1] * inv; v2u o;
                o.x = (unsigned)(__float2int_rn(a.x) & 255) | ((unsigned)(__float2int_rn(a.y) & 255) << 8) | ((unsigned)(__float2int_rn(a.z) & 255) << 16) | ((unsigned)__float2int_rn(a.w) << 24);
                o.y = (unsigned)(__float2int_rn(c.x) & 255) | ((unsigned)(__float2int_rn(c.y) & 255) << 8) | ((unsigned)(__float2int_rn(c.z) & 255) << 16) | ((unsigned)__float2int_rn(c.w) << 24);
                *(GAS v2u*)(hq + 8 * lane + 512 * j) = o; }
            if (lane == 0) SArow0[r] = mx[r] * (1.f / 127.f); }
    }
    if (SMALL) {
        float p[32];
#pragma unroll
        for (int q = 0; q < 8; ++q) {
            f32x2 e0 = {0.f, 0.f}, e1 = {0.f, 0.f}, e2 = {0.f, 0.f}, e3 = {0.f, 0.f};
#pragma unroll
            for (int j = 0; j < 4; ++j) { const f32x4 w = ((const LAS f32x4*)wl)[(q * 4 + j) * 64 + lane];
                const f32x2 wl2 = __builtin_shufflevector(w, w, 0, 1), wh2 = __builtin_shufflevector(w, w, 2, 3);
                e0 = __builtin_shufflevector(v[0][j], v[0][j], 0, 1) * wl2 + e0; e0 = __builtin_shufflevector(v[0][j], v[0][j], 2, 3) * wh2 + e0;
                e1 = __builtin_shufflevector(v[1][j], v[1][j], 0, 1) * wl2 + e1; e1 = __builtin_shufflevector(v[1][j], v[1][j], 2, 3) * wh2 + e1;
                e2 = __builtin_shufflevector(v[2][j], v[2][j], 0, 1) * wl2 + e2; e2 = __builtin_shufflevector(v[2][j], v[2][j], 2, 3) * wh2 + e2;
                e3 = __builtin_shufflevector(v[3][j], v[3][j], 0, 1) * wl2 + e3; e3 = __builtin_shufflevector(v[3][j], v[3][j], 2, 3) * wh2 + e3; }
            const float d0 = e0.x + e0.y, d1 = e1.x + e1.y, d2 = e2.x + e2.y, d3 = e3.x + e3.y;
            p[q] = d0; p[8 + q] = d1; p[16 + q] = d2; p[24 + q] = d3; }
        BFLY_STEP(32, 1); BFLY_STEP(16, 2); BFLY_STEP(8, 4); BFLY_STEP(4, 8); BFLY_STEP(2, 16);
        const float tot = p[0] + __shfl_xor(p[0], 32);
        if (lane < 32) Srow0[lane] = tot + bsm[lane & 7];
    }
}
template <bool SMALL, bool XF32, bool QOUT>
__device__ __forceinline__ void norm_phase(Frame& F, const void* xin, const float* g, const float* modsc, const float* modsh, bf16* H, const float* wsm, const float* bsm, float* S) {
    const int gw = F.vcu * NWAVES + F.wave, NGW = F.G * NWAVES, lane = F.lane;
    LAS float* wl = (LAS float*)(F.lds + RING_OFF);
    if (SMALL) { __syncthreads();
        for (int i = F.tid; i < 8 * D / 4; i += NWAVES * 64) { const int q = i >> 8, col = (i & 255) * 4, ln = (col & 511) >> 3, j = 2 * (col >> 9) + ((col & 7) >> 2); ((LAS f32x4*)wl)[(q * 4 + j) * 64 + ln] = ((const f32x4*)wsm)[i]; }
        __syncthreads(); }
    for (int blk = gw; blk < T / 16; blk += NGW) {
        const int row0 = blk * 16, b = row0 / SEQ;
        f32x4 gs[4], shv[4];
#pragma unroll
        for (int j = 0; j < 4; ++j) { const int col = 8 * lane + 512 * (j >> 1) + 4 * (j & 1); const f32x4 gv = *(const f32x4*)(g + col), sc = *(const f32x4*)(modsc + b * 6144 + col);
            gs[j] = gv * (sc + 1.f); shv[j] = *(const f32x4*)(modsh + b * 6144 + col); }
        bf16* Hb = QOUT ? (bf16*)((signed char*)H + (size_t)row0 * D) : H + (size_t)row0 * D; float* Sb = S + (size_t)row0 * 8;
        v4u raw_n[4][2];
#define NORM_RAW(bt_) do { _Pragma("unroll") for (int r = 0; r < 4; ++r) _Pragma("unroll") for (int j = 0; j < 2; ++j) \
            raw_n[r][j] = *(const GAS v4u*)((const bf16*)xin + ((size_t)row0 + 4 * (bt_) + r) * D + 8 * lane + 512 * j); } while (0)
        if (!XF32) NORM_RAW(0);
        for (int bt = 0; bt < 4; ++bt) {
            f32x4 va[4][4];
            if (XF32) norm_load<true>(va, xin, (size_t)row0 + 4 * bt, lane);
            else {
#pragma unroll
                for (int r = 0; r < 4; ++r)
#pragma unroll
                    for (int j = 0; j < 2; ++j) { const v4u x = raw_n[r][j];
                        va[r][2 * j] = (f32x4){bflo(x.x), bfhi(x.x), bflo(x.y), bfhi(x.y)}; va[r][2 * j + 1] = (f32x4){bflo(x.z), bfhi(x.z), bflo(x.w), bfhi(x.w)}; }
                if (bt < 3) NORM_RAW(bt + 1);
            }
            if (XF32) {
#pragma unroll
                for (int r = 0; r < 4; ++r)
#pragma unroll
                    for (int j = 0; j < 2; ++j) { v4u o; o.x = pk2(va[r][2 * j].x, va[r][2 * j].y); o.y = pk2(va[r][2 * j].z, va[r][2 * j].w); o.z = pk2(va[r][2 * j + 1].x, va[r][2 * j + 1].y); o.w = pk2(va[r][2 * j + 1].z, va[r][2 * j + 1].w);
                        *(GAS v4u*)(F.XB + ((size_t)row0 + 4 * bt + r) * D + 8 * lane + 512 * j) = o; }
            }
            int wo = 0; asm volatile("" : "+v"(wo));
            norm_batch<SMALL, QOUT>(va, gs, shv, QOUT ? (bf16*)((signed char*)Hb + (size_t)bt * 4 * D) : Hb + (size_t)bt * 4 * D, wl + wo, bsm, Sb + bt * 32, lane, F.SA + row0 + 4 * bt);
        }
    }
}
__device__ __forceinline__ void final_norm(Frame& F) {
    const int gw = F.vcu * NWAVES + F.wave, NGW = F.G * NWAVES, lane = F.lane;
    f32x4 gs[4];
#pragma unroll
    for (int j = 0; j < 4; ++j) gs[j] = *(const f32x4*)(F.g_final + 8 * lane + 512 * (j >> 1) + 4 * (j & 1));
    const int nT1 = __builtin_amdgcn_readfirstlane(F.NT[1]);
    const bool tail = MOE_TAIL && F.G == 256 && nT1 > 128;
    const int R1 = nT1 * 4 - 2 * F.G, S1 = tail ? pg8::tail_slices(R1, F.G, MOE_DOWN_KT, PART_SLOTS) : 1, P0 = tail ? __builtin_amdgcn_readfirstlane(F.TILES[(MAXTILES + 128) * 4 + 1]) : T;
    const float* gbase = F.MOD + 4 * 6144 + 5120 + 8 * lane;
#define FIN_D0ROW(p_) ((p_) < D0_SPLIT ? F.D0A + (size_t)(p_) * D : F.D0B + (size_t)((p_) - D0_SPLIT) * D)
    for (int blk = gw; blk < T / 16; blk += NGW) {
        const int pv_ = lane < 16 ? F.POS0[blk * 16 + lane] : (lane < 32 ? F.POS1[blk * 16 + lane - 16] : 0);
        f32x4 gt[4];
#pragma unroll
        for (int j = 0; j < 4; ++j) gt[j] = *(const f32x4*)(gbase + (size_t)(blk >> 9) * 6144 + 512 * (j >> 1) + 4 * (j & 1)) * (1.f / F8_DS);
        v4u raw_n[2][2]; v2u raw_d[2][2][2];
#define FIN_RAW(bt_) do { _Pragma("unroll") for (int r = 0; r < 2; ++r) { const int p0_ = __builtin_amdgcn_readlane(pv_, 2 * (bt_) + r), p1_ = __builtin_amdgcn_readlane(pv_, 16 + 2 * (bt_) + r); \
            const bf16* x_ = F.XB + ((size_t)blk * 16 + 2 * (bt_) + r) * D; const signed char* a_ = (const signed char*)F.D0A + (size_t)p0_ * D; const signed char* b_ = (const signed char*)F.D1 + (size_t)(p1_ < P0 ? p1_ : 0) * D; \
            _Pragma("unroll") for (int j = 0; j < 2; ++j) { raw_n[r][j] = *(const GAS v4u*)(x_ + 8 * lane + 512 * j); raw_d[r][0][j] = *(const GAS v2u*)(a_ + 8 * lane + 512 * j); raw_d[r][1][j] = *(const GAS v2u*)(b_ + 8 * lane + 512 * j); } } } while (0)
        FIN_RAW(0);
#pragma unroll 1
        for (int bt = 0; bt < 8; ++bt) { f32x4 va[2][4]; const size_t row = (size_t)blk * 16 + 2 * bt; int p1r[2];
#pragma unroll
            for (int r = 0; r < 2; ++r) { p1r[r] = __builtin_amdgcn_readlane(pv_, 16 + 2 * bt + r);
#pragma unroll
                for (int j = 0; j < 2; ++j) { const v4u x = raw_n[r][j]; const v2u a = raw_d[r][0][j], b = raw_d[r][1][j];
                    va[r][2 * j] = (f32x4){bflo(x.x), bfhi(x.x), bflo(x.y), bfhi(x.y)} + gt[2 * j] * (fp8x4_f(a.x) + fp8x4_f(b.x));
                    va[r][2 * j + 1] = (f32x4){bflo(x.z), bfhi(x.z), bflo(x.w), bfhi(x.w)} + gt[2 * j + 1] * (fp8x4_f(a.y) + fp8x4_f(b.y)); } }
            if (bt < 7) FIN_RAW(bt + 1);
            float s_[2];
#pragma unroll
            for (int r = 0; r < 2; ++r) { s_[r] = 0.f;
#pragma unroll
                for (int j = 0; j < 4; ++j) s_[r] += (va[r][j].x * va[r][j].x + va[r][j].y * va[r][j].y) + (va[r][j].z * va[r][j].z + va[r][j].w * va[r][j].w); }
#pragma unroll
            for (int r = 0; r < 2; ++r) s_[r] = wave_sum_dpp(s_[r]);
#pragma unroll
            for (int r = 0; r < 2; ++r) { const float rstd = __builtin_amdgcn_rsqf(s_[r] * (1.f / D) + EPS);
                if (p1r[r] < P0) {
#pragma unroll
                    for (int j = 0; j < 4; ++j) *(GAS f32x4*)(F.out + (row + r) * D + 8 * lane + 512 * (j >> 1) + 4 * (j & 1)) = va[r][j] * rstd * gs[j]; } } }
    }
    if (tail) {
        for (int i = gw; i < T - P0; i += NGW) {
            const int pos = P0 + i, tok = __builtin_amdgcn_readfirstlane(F.PERM[T + pos]); const float pwv = F.PW[T + pos];
            const int pos0 = __builtin_amdgcn_readfirstlane(F.POS0[tok]);
            int t = 128; while (t + 1 < nT1 && pos >= __builtin_amdgcn_readfirstlane(F.TILES[(MAXTILES + t + 1) * 4 + 1])) ++t;
            const int rl = pos - __builtin_amdgcn_readfirstlane(F.TILES[(MAXTILES + t) * 4 + 1]);
            const float* gp = F.MOD + 4 * 6144 + (size_t)(tok >> 13) * 6144 + 5120;
            f32x4 va[4], da[4];
#pragma unroll
            for (int j = 0; j < 2; ++j) { const v4u x = *(const GAS v4u*)(F.XB + (size_t)tok * D + 8 * lane + 512 * j); const v2u a = *(const GAS v2u*)((const signed char*)F.D0A + (size_t)pos0 * D + 8 * lane + 512 * j);
                va[2 * j] = (f32x4){bflo(x.x), bfhi(x.x), bflo(x.y), bfhi(x.y)}; va[2 * j + 1] = (f32x4){bflo(x.z), bfhi(x.z), bflo(x.w), bfhi(x.w)};
                da[2 * j] = fp8x4_f(a.x) * (1.f / F8_DS); da[2 * j + 1] = fp8x4_f(a.y) * (1.f / F8_DS); }
#pragma unroll
            for (int jh = 0; jh < 2; ++jh) {
                f32x4 pk[2][11];
#pragma unroll
                for (int jj = 0; jj < 2; ++jj) { const int j = 2 * jh + jj, col = 8 * lane + 512 * (j >> 1) + 4 * (j & 1), pn = col >> 8, cc = col & 255;
                    const float* pp = F.PART + ((size_t)((t - 128) * 4 + pn) * S1) * 65536 + (size_t)rl * 256 + cc;
#pragma unroll
                    for (int k = 0; k < 11; ++k) { pk[jj][k] = zero4(); if (k < S1) pk[jj][k] = *(const f32x4*)(pp + (size_t)k * 65536); } }
#pragma unroll
                for (int jj = 0; jj < 2; ++jj) { const int j = 2 * jh + jj, col = 8 * lane + 512 * (j >> 1) + 4 * (j & 1); f32x4 sum = pk[jj][0];
#pragma unroll
                    for (int k = 1; k < 11; ++k) sum += pk[jj][k];
                    va[j] += *(const f32x4*)(gp + col) * (da[j] + (pwv * (FP8_MOE ? 1.f / (F8_HS * F8_WS) : 1.f)) * sum); } }
            float s = 0.f;
#pragma unroll
            for (int j = 0; j < 4; ++j) s += (va[j].x * va[j].x + va[j].y * va[j].y) + (va[j].z * va[j].z + va[j].w * va[j].w);
            s = wave_sum(s);
            const float rstd = __builtin_amdgcn_rsqf(s * (1.f / D) + EPS);
#pragma unroll
            for (int j = 0; j < 4; ++j) *(GAS f32x4*)(F.out + (size_t)tok * D + 8 * lane + 512 * (j >> 1) + 4 * (j & 1)) = va[j] * rstd * gs[j];
        }
    }
}

__device__ __forceinline__ void lru_scan(Frame& F) {
    for (int gid = blockIdx.x * (NWAVES * 64) + F.tid; gid < NB * 512; gid += F.G * NWAVES * 64) {
        const int b = gid >> 9, ch = gid & 511; float h = 0.f;
        for (int s0 = 0; s0 < 64; s0 += 32) {
            f32x2 cv[32];
#pragma unroll
            for (int i = 0; i < 32; ++i) cv[i] = *(const f32x2*)(F.CAR + (size_t)((b * 64 + s0 + i) * 512 + ch) * 2);
#pragma unroll
            for (int i = 0; i < 32; ++i) { F.HIN[(b * 64 + s0 + i) * 512 + ch] = h; h = cv[i].x * h + cv[i].y; } }
    }
}


typedef short bf16x8 __attribute__((ext_vector_type(8)));
__device__ __forceinline__ f32x4 mma16(bf16x8 a, bf16x8 b, f32x4 c) { return __builtin_amdgcn_mfma_f32_16x16x32_bf16(a, b, c, 0, 0, 0); }
__device__ __forceinline__ bf16x8 ldfrag(const LAS bf16* base, int ld, int r0, int k0, int lane) { return *(const LAS bf16x8*)(base + (r0 + (lane & 15)) * ld + k0 + 8 * (lane >> 4)); }
__device__ __forceinline__ float shfl_up_f(float v, int d) { return __shfl_up(v, d); }

constexpr int ML_NCH = 8, ML_NSG = SEQ / (64 * ML_NCH), ML_UNITS = 16 * ML_NSG;
constexpr int CL_STRIDE = 129 * 128;
__device__ __forceinline__ void mlstm_scan(Frame& F) {
    for (int gid = blockIdx.x * (NWAVES * 64) + F.tid; gid < 16 * CL_STRIDE; gid += F.G * NWAVES * 64) {
        const int bh = gid / CL_STRIDE, e = gid % CL_STRIDE;
        float cs = 0.f, m = 0.f;
        float* p = F.CLOC + (size_t)bh * ML_NSG * CL_STRIDE + e;
        float xs[ML_NSG];
#pragma unroll
        for (int sg = 0; sg < ML_NSG; ++sg) xs[sg] = p[(size_t)sg * CL_STRIDE];
#pragma unroll
        for (int sg = 0; sg < ML_NSG; ++sg) { const float ml = F.MST[bh * ML_NSG + sg], bt = F.MST[512 + bh * ML_NSG + sg];
            p[(size_t)sg * CL_STRIDE] = cs; if (e == 0) F.MST[1024 + bh * ML_NSG + sg] = m;
            const float mn = fmaxf(bt + m, ml); cs = __expf(bt + m - mn) * cs + __expf(ml - mn) * xs[sg]; m = mn; }
    }
}

constexpr int LRU_WAVE_BYTES = 6656, LRU_RED_OFF = 8 * LRU_WAVE_BYTES;

typedef short v4i16_t __attribute__((ext_vector_type(4)));
__device__ __forceinline__ bf16x8 ldfrag_tr(const LAS bf16* base, int ld, int k0, int c0, int lane) {
    const int g = lane >> 4, q = (lane & 15) >> 2, p = lane & 3;
    const LAS bf16* a0 = base + (k0 + 8 * g + q) * ld + c0 + 4 * p;
    const v4i16_t lo = __builtin_amdgcn_ds_read_tr16_b64_v4i16((LAS v4i16_t*)a0), hi = __builtin_amdgcn_ds_read_tr16_b64_v4i16((LAS v4i16_t*)(a0 + 4 * ld));
    bf16x8 r; r[0] = lo[0]; r[1] = lo[1]; r[2] = lo[2]; r[3] = lo[3]; r[4] = hi[0]; r[5] = hi[1]; r[6] = hi[2]; r[7] = hi[3]; return r;
}
constexpr int M2_Q = 0, M2_KG = 17408, M2_P = 34816, M2_V = 44032, M2_CT = 63488, M2_TAB = 102400;
template <bool OUT>
__device__ __forceinline__ void mlstm_unit2(Frame& F, int l, int u) {
    const int bh = u / ML_NSG, sg = u % ML_NSG, b = bh >> 2, h = bh & 3;
    int tid_ = F.tid; asm volatile("" : "+v"(tid_));
    const int tid = tid_, lane = tid & 63, w = F.wave, lr = lane & 15, lq = lane >> 4;
    LAS bf16* Qs = (LAS bf16*)(F.lds + M2_Q); LAS bf16* KG = (LAS bf16*)(F.lds + M2_KG); LAS bf16* Vs = (LAS bf16*)(F.lds + M2_V);
    LAS bf16* Ps = (LAS bf16*)(F.lds + M2_P); LAS bf16* CT = (LAS bf16*)(F.lds + M2_CT); LAS float* NUM = (LAS float*)(F.lds + M2_Q);
    LAS float* TAB = (LAS float*)(F.lds + M2_TAB);
    LAS float* pre = TAB; LAS float* gsc = TAB + 192 * ML_NCH; LAS float* tb = gsc + 16; LAS float* sc = tb + 256 * ML_NCH; LAS float* cwl = sc + 16;
    const size_t row0 = (size_t)b * SEQ + 64 * ML_NCH * sg;
    float* cl = F.CLOC + (size_t)u * CL_STRIDE;
    const int mat = tid >> 8, dg = tid & 15, tg = (tid >> 4) & 15, ccol = mat * 512 + h * 128 + 8 * dg;
    float g0 = 0.f, g1 = 0.f;
    if (OUT) { g0 = F.g_mix_out[l * 1024 + h * 128 + 2 * lane]; g1 = F.g_mix_out[l * 1024 + h * 128 + 2 * lane + 1]; }
    f32x4 Cacc[9];
    __syncthreads();
    for (int i = tid; i < 1280; i += NWAVES * 64) { const int mm = i / 640, jj = (i % 640) >> 7, d = i & 127;
        cwl[i] = -1.4426950408889634f * (jj < 4 ? F.w_conv_qk[l * 4096 + jj * 1024 + mm * 512 + h * 128 + d] : F.b_conv_qk[l * 1024 + mm * 512 + h * 128 + d]); }
    if (tid < 192) { const int t = tid / 3, c8 = tid % 3; *(LAS v4u*)(Vs + t * 152 + 128 + 8 * c8) = (v4u){c8 == 0 ? 0x3f80u : 0u, 0u, 0u, 0u}; }
    if (w < ML_NCH) { const size_t rg = row0 + 64 * w + lane;
        const float ig = F.G8[rg * 8 + h], lf = logsigmoid_f(F.G8[rg * 8 + 4 + h]);
        float bb = lf;
#pragma unroll
        for (int o = 1; o < 64; o <<= 1) { const float v = shfl_up_f(bb, o); if (lane >= o) bb += v; }
        const float cv = ig - bb; float pm = cv;
#pragma unroll
        for (int o = 1; o < 64; o <<= 1) { const float v = shfl_up_f(pm, o); if (lane >= o) pm = fmaxf(pm, v); }
        pre[(w * 3 + 0) * 64 + lane] = bb; pre[(w * 3 + 1) * 64 + lane] = cv; pre[(w * 3 + 2) * 64 + lane] = pm;
        if (lane == 63) { gsc[2 * w] = bb; gsc[2 * w + 1] = pm; } }
    if (OUT) {
#pragma unroll
        for (int nt = 0; nt < 8; ++nt) { f32x4 c4;
#pragma unroll
            for (int i = 0; i < 4; ++i) c4[i] = cl[(16 * w + 4 * lq + i) * 128 + 16 * nt + lr];
            Cacc[nt] = c4;
            v2u pk; pk.x = pg8::cvt_pk_bf16(c4[0], c4[1]); pk.y = pg8::cvt_pk_bf16(c4[2], c4[3]); *(LAS v2u*)(CT + (16 * nt + lr) * 152 + 16 * w + 4 * lq) = pk; }
        { const float nv = (lq == 0) ? cl[128 * 128 + 16 * w + lr] : 0.f; Cacc[8] = (f32x4){nv, 0.f, 0.f, 0.f};
          v2u pk; pk.x = pg8::cvt_pk_bf16(nv, 0.f); pk.y = 0u; *(LAS v2u*)(CT + (16 * w + lr) * 152 + 128 + 4 * lq) = pk; }
    } else {
#pragma unroll
        for (int nt = 0; nt < 9; ++nt) Cacc[nt] = zero4();
    }
    v4u xr[7], xv[2];
#define M2_FETCH(jc) do { const size_t rc_ = row0 + 64 * (jc); const int p0_ = 64 * ML_NCH * sg + 64 * (jc); \
        if (OUT || mat == 1) { _Pragma("unroll") for (int i = 0; i < 7; ++i) { const int p = p0_ + 4 * tg - 3 + i; \
            xr[i] = (p >= 0) ? *(const v4u*)(F.Z + (rc_ + 4 * tg - 3 + i) * NZ + ccol) : (v4u){0u, 0u, 0u, 0u}; } } \
        _Pragma("unroll") for (int hh = 0; hh < 2; ++hh) xv[hh] = *(const v4u*)(F.Z + (rc_ + (tid >> 3)) * NZ + 1024 + h * 128 + 8 * ((tid & 7) + 8 * hh)); } while (0)
    M2_FETCH(0);
    __syncthreads();
    if (w < ML_NCH) {
        float m = OUT ? F.MST[1024 + u] : -1e30f, btot = 0.f;
        for (int c = 0; c < w; ++c) { const float bl = gsc[2 * c], pl = gsc[2 * c + 1]; m = fmaxf(bl + m, bl + pl); btot += bl; }
        const float bl = gsc[2 * w], pl = gsc[2 * w + 1], m_new = fmaxf(bl + m, bl + pl);
        const float bb = pre[(w * 3 + 0) * 64 + lane], cv = pre[(w * 3 + 1) * 64 + lane], pm = pre[(w * 3 + 2) * 64 + lane];
        const float mt_ = bb + fmaxf(m, pm);
        tb[(w * 4 + 0) * 64 + lane] = __expf(bb - mt_ - bl + m_new);
        tb[(w * 4 + 1) * 64 + lane] = __expf(bl + cv - m_new);
        tb[(w * 4 + 2) * 64 + lane] = __expf(bb + m - mt_);
        tb[(w * 4 + 3) * 64 + lane] = __expf(-mt_);
        if (lane == 0) { sc[w] = __expf(bl + m - m_new); if (w == ML_NCH - 1) { sc[8] = m_new; sc[9] = btot + bl; } }
    }
    for (int j = 0; j < ML_NCH; ++j) {
        const size_t rc = row0 + 64 * j;
        __syncthreads();
        if (OUT || mat == 1) {
            f32x4 cwa[5], cwb[5];
#pragma unroll
            for (int jj = 0; jj < 5; ++jj) { cwa[jj] = *(const LAS f32x4*)(cwl + (mat * 5 + jj) * 128 + 8 * dg); cwb[jj] = *(const LAS f32x4*)(cwl + (mat * 5 + jj) * 128 + 8 * dg + 4); }
#pragma unroll
            for (int tt = 0; tt < 4; ++tt) { f32x2 o[4];
                o[0] = __builtin_shufflevector(cwa[4], cwa[4], 0, 1); o[1] = __builtin_shufflevector(cwa[4], cwa[4], 2, 3); o[2] = __builtin_shufflevector(cwb[4], cwb[4], 0, 1); o[3] = __builtin_shufflevector(cwb[4], cwb[4], 2, 3);
#pragma unroll
                for (int jj = 0; jj < 4; ++jj) { const v4u x = xr[tt + jj];
                    o[0] = __builtin_shufflevector(cwa[jj], cwa[jj], 0, 1) * (f32x2){bflo(x.x), bfhi(x.x)} + o[0]; o[1] = __builtin_shufflevector(cwa[jj], cwa[jj], 2, 3) * (f32x2){bflo(x.y), bfhi(x.y)} + o[1];
                    o[2] = __builtin_shufflevector(cwb[jj], cwb[jj], 0, 1) * (f32x2){bflo(x.z), bfhi(x.z)} + o[2]; o[3] = __builtin_shufflevector(cwb[jj], cwb[jj], 2, 3) * (f32x2){bflo(x.w), bfhi(x.w)} + o[3]; }
                const float scl = -0.6931471805599453f * (mat ? 0.08838834764831845f * tb[(j * 4 + 1) * 64 + 4 * tg + tt] : 1.f); const f32x2 scl2 = {scl, scl};
                unsigned pkw[4];
#pragma unroll
                for (int e = 0; e < 4; ++e) { const f32x2 den = (f32x2){__builtin_amdgcn_exp2f(o[e].x), __builtin_amdgcn_exp2f(o[e].y)} + (f32x2){1.f, 1.f};
                    const f32x2 res = (o[e] * scl2) * (f32x2){__builtin_amdgcn_rcpf(den.x), __builtin_amdgcn_rcpf(den.y)}; pkw[e] = pg8::cvt_pk_bf16(res.x, res.y); }
                v4u pk; pk.x = pkw[0]; pk.y = pkw[1]; pk.z = pkw[2]; pk.w = pkw[3];
                *(LAS v4u*)((mat ? KG : Qs) + (4 * tg + tt) * 136 + 8 * dg) = pk;
                __builtin_amdgcn_sched_barrier(0); }
        }
        { const int t = tid >> 3;
#pragma unroll
          for (int hh = 0; hh < 2; ++hh) *(LAS v4u*)(Vs + t * 152 + 8 * ((tid & 7) + 8 * hh)) = xv[hh]; }
        __builtin_amdgcn_sched_barrier(0);
        if (j < ML_NCH - 1) M2_FETCH(j + 1);
        __syncthreads();
        if (OUT) {
            { const int ms = w & 3;
              bf16x8 ak[4];
#pragma unroll
              for (int ks = 0; ks < 4; ++ks) ak[ks] = ldfrag(KG, 136, 16 * ms, 32 * ks, lane);
#pragma unroll
              for (int jn = 0; jn < 2; ++jn) { const int nt = 2 * (w >> 2) + jn;
                  f32x4 s = zero4();
                  if (ms <= nt) {
#pragma unroll
                      for (int ks = 0; ks < 4; ++ks) s = mma16(ak[ks], ldfrag(Qs, 136, 16 * nt, 32 * ks, lane), s);
                  }
                  const int t = 16 * nt + lr, s0 = 16 * ms + 4 * lq; const float rf = tb[(j * 4 + 0) * 64 + t];
                  v2u pk; pk.x = pg8::cvt_pk_bf16(s0 <= t ? s[0] * rf : 0.f, s0 + 1 <= t ? s[1] * rf : 0.f); pk.y = pg8::cvt_pk_bf16(s0 + 2 <= t ? s[2] * rf : 0.f, s0 + 3 <= t ? s[3] * rf : 0.f);
                  *(LAS v2u*)(Ps + t * 72 + s0) = pk; } }
            __syncthreads();
        }
        f32x4 accD[5]; const int mtD = w & 3, ntb = 4 * (w >> 2), ntn = 4 + (w >> 2);
        unsigned ov8[8];
        if (OUT) {
#pragma unroll
            for (int r = 0; r < 8; ++r) ov8[r] = *(const unsigned*)(F.Z + (rc + 8 * w + r) * NZ + 1536 + h * 128 + 2 * lane);
            bf16x8 aq[4], ap[2];
#pragma unroll
            for (int ks = 0; ks < 4; ++ks) aq[ks] = ldfrag(Qs, 136, 16 * mtD, 32 * ks, lane);
#pragma unroll
            for (int ks = 0; ks < 2; ++ks) ap[ks] = ldfrag(Ps, 72, 16 * mtD, 32 * ks, lane);
            float is4[4];
#pragma unroll
            for (int i = 0; i < 4; ++i) is4[i] = tb[(j * 4 + 2) * 64 + 16 * mtD + 4 * lq + i];
#pragma unroll
            for (int jn = 0; jn < 5; ++jn) { f32x4 a4 = zero4();
                if (jn < ntn) { const int nt = ntb + jn;
                    __builtin_amdgcn_sched_barrier(0);
#pragma unroll
                    for (int ks = 0; ks < 4; ++ks) a4 = mma16(aq[ks], ldfrag_tr(CT, 152, 32 * ks, 16 * nt, lane), a4);
                    a4[0] *= is4[0]; a4[1] *= is4[1]; a4[2] *= is4[2]; a4[3] *= is4[3];
#pragma unroll
                    for (int ks = 0; ks < 2; ++ks) a4 = mma16(ap[ks], ldfrag_tr(Vs, 152, 32 * ks, 16 * nt, lane), a4); }
                accD[jn] = a4; }
        }
        { const float a = sc[j];
          bf16x8 av[2];
#pragma unroll
          for (int ks = 0; ks < 2; ++ks) av[ks] = ldfrag_tr(Vs, 152, 32 * ks, 16 * w, lane);
#pragma unroll
          for (int nt = 0; nt < 8; ++nt) { f32x4 c4 = Cacc[nt] * a;
#pragma unroll
              for (int ks = 0; ks < 2; ++ks) c4 = mma16(av[ks], ldfrag_tr(KG, 136, 32 * ks, 16 * nt, lane), c4);
              Cacc[nt] = c4; }
          { f32x4 c4 = Cacc[8] * a;
#pragma unroll
            for (int ks = 0; ks < 2; ++ks) c4 = mma16(ldfrag_tr(Vs, 152, 32 * ks, 128, lane), ldfrag_tr(KG, 136, 32 * ks, 16 * w, lane), c4);
            Cacc[8] = c4; } }
        if (OUT) {
            __syncthreads();
#pragma unroll
            for (int jn = 0; jn < 5; ++jn) if (jn < ntn) {
#pragma unroll
                for (int i = 0; i < 4; ++i) NUM[(16 * mtD + 4 * lq + i) * 148 + 16 * (ntb + jn) + lr] = accD[jn][i]; }
#pragma unroll
            for (int nt = 0; nt < 8; ++nt) { const f32x4 c4 = Cacc[nt]; v2u pk; pk.x = pg8::cvt_pk_bf16(c4[0], c4[1]); pk.y = pg8::cvt_pk_bf16(c4[2], c4[3]); *(LAS v2u*)(CT + (16 * nt + lr) * 152 + 16 * w + 4 * lq) = pk; }
            { const f32x4 c4 = Cacc[8]; v2u pk; pk.x = pg8::cvt_pk_bf16(c4[0], c4[1]); pk.y = pg8::cvt_pk_bf16(c4[2], c4[3]); *(LAS v2u*)(CT + (16 * w + lr) * 152 + 128 + 4 * lq) = pk; }
            __syncthreads();
#pragma unroll
            for (int r = 0; r < 8; ++r) { const int t = 8 * w + r;
                const f32x2 nv = *(const LAS f32x2*)(NUM + t * 148 + 2 * lane); const float dn = __builtin_amdgcn_rcpf(fmaxf(fabsf(NUM[t * 148 + 128]), tb[(j * 4 + 3) * 64 + t]));
                const float h0 = nv.x * dn, h1 = nv.y * dn;
                const float ss = wave_sum(h0 * h0 + h1 * h1);
                const float rstd = __builtin_amdgcn_rsqf(ss * (1.f / 128.f) + EPS);
                const unsigned ov = ov8[r];
                *(unsigned*)(F.HB + (rc + t) * D + h * 128 + 2 * lane) = pk2(h0 * rstd * g0 * __builtin_amdgcn_rcpf(1.f + __builtin_amdgcn_exp2f(bflo(ov))), h1 * rstd * g1 * __builtin_amdgcn_rcpf(1.f + __builtin_amdgcn_exp2f(bfhi(ov)))); }
        }
    }
    if (!OUT) {
#pragma unroll
        for (int nt = 0; nt < 8; ++nt)
#pragma unroll
            for (int i = 0; i < 4; ++i) cl[(16 * w + 4 * lq + i) * 128 + 16 * nt + lr] = Cacc[nt][i];
        if (lq == 0) cl[128 * 128 + 16 * w + lr] = Cacc[8][0];
        if (tid == 0) { F.MST[u] = sc[8]; F.MST[512 + u] = sc[9]; }
    }
#undef M2_FETCH
}

#define LRU_SCAN_STEP(N_) do { asm volatile("s_nop 1" ::: "memory"); _Pragma("unroll") for (int e_ = 0; e_ < 16; ++e_) { \
        asm volatile("v_fmac_f32_dpp %0, %0, %1 row_shr:" #N_ " row_mask:0xf bank_mask:0xf" : "+v"(Us[e_]) : "v"(As[e_])); \
        asm volatile("v_mul_f32_dpp %0, %0, %0 row_shr:" #N_ " row_mask:0xf bank_mask:0xf" : "+v"(As[e_])); } } while (0)
__device__ __forceinline__ float row_bcast15_nn(float v) { float r; asm volatile("v_mov_b32_dpp %0, %1 row_newbcast:15 row_mask:0xf bank_mask:0xf" : "=v"(r) : "v"(v)); return r; }
__device__ __forceinline__ float row_bcast15(float v) { float r; asm volatile("s_nop 1\n\tv_mov_b32_dpp %0, %1 row_newbcast:15 row_mask:0xf bank_mask:0xf" : "=v"(r) : "v"(v)); return r; }
template <bool OUT>
__device__ __forceinline__ void lru2(Frame& F, int l) {
    const int lane = F.lane, n = F.wave, lr = lane & 15, lq = lane >> 4;
    LAS float* XC = (LAS float*)(F.lds + n * LRU_WAVE_BYTES);
    LAS float* CW = XC + 16 * 68;
    LAS float* CN = CW + 320;
    LAS float* red = (LAS float*)(F.lds + LRU_RED_OFF);
    bf16* LU = F.ASORT;
    __syncthreads();
    CN[192 + lane] = F.g_mix_out[l * 1024 + 512 + 64 * n + lane];
    bf16x8 fa[4][2], fx[4][2];
    if (!OUT) {
#pragma unroll
        for (int j = 0; j < 4; ++j) CW[j * 64 + lane] = F.w_conv_lru[l * 2048 + j * 512 + 64 * n + lane];
        CW[256 + lane] = F.b_conv_lru[l * 512 + 64 * n + lane];
        const float NL2E = -1.4426950408889634f;
        CN[lane] = NL2E * F.b_lru_a[l * 512 + 64 * n + lane]; CN[64 + lane] = NL2E * F.b_lru_x[l * 512 + 64 * n + lane];
        CN[128 + lane] = 8.f * NL2E * softplus_f(-F.lru_lambda[l * 512 + 64 * n + lane]);
        const float* WA = F.w_lru_a + (size_t)l * 8 * 4096 + n * 4096; const float* WX = F.w_lru_x + (size_t)l * 8 * 4096 + n * 4096;
#pragma unroll
        for (int mt = 0; mt < 4; ++mt)
#pragma unroll
            for (int ks = 0; ks < 2; ++ks) { const int e = 16 * mt + lr, d0 = 32 * ks + 8 * lq; v4u pa, px;
                pa.x = pk2(NL2E * WA[(d0 + 0) * 64 + e], NL2E * WA[(d0 + 1) * 64 + e]); pa.y = pk2(NL2E * WA[(d0 + 2) * 64 + e], NL2E * WA[(d0 + 3) * 64 + e]); pa.z = pk2(NL2E * WA[(d0 + 4) * 64 + e], NL2E * WA[(d0 + 5) * 64 + e]); pa.w = pk2(NL2E * WA[(d0 + 6) * 64 + e], NL2E * WA[(d0 + 7) * 64 + e]);
                px.x = pk2(NL2E * WX[(d0 + 0) * 64 + e], NL2E * WX[(d0 + 1) * 64 + e]); px.y = pk2(NL2E * WX[(d0 + 2) * 64 + e], NL2E * WX[(d0 + 3) * 64 + e]); px.z = pk2(NL2E * WX[(d0 + 4) * 64 + e], NL2E * WX[(d0 + 5) * 64 + e]); px.w = pk2(NL2E * WX[(d0 + 6) * 64 + e], NL2E * WX[(d0 + 7) * 64 + e]);
                fa[mt][ks] = __builtin_bit_cast(bf16x8, pa); fx[mt][ks] = __builtin_bit_cast(bf16x8, px); }
    }
    for (int u = blockIdx.x; u < 256; u += F.G) {
        const int b = u >> 6, sg = u & 63, s0 = 128 * sg;
        const size_t row0 = (size_t)b * SEQ + s0;
        float hst[16], atot[16];
#pragma unroll
        for (int e = 0; e < 16; ++e) { hst[e] = OUT ? F.HIN[(b * 64 + sg) * 512 + 64 * n + 16 * (e >> 2) + 4 * lq + (e & 3)] : 0.f; atot[e] = 1.f; }
        v4u lu_n[4], xc_n[8]; v2u gl_n[4];
#define LRU_FETCH(tau_) do { const size_t rt_ = row0 + 16 * (tau_); \
            if (OUT) { _Pragma("unroll") for (int mt = 0; mt < 4; ++mt) { lu_n[mt] = *(const v4u*)(LU + ((rt_ + lr) * 512 + 64 * n + 16 * mt + 4 * lq) * 2); gl_n[mt] = *(const v2u*)(F.Z + (rt_ + lr) * NZ + 2560 + 64 * n + 16 * mt + 4 * lq); } } \
            else { const int t_ = lane >> 2, cg_ = lane & 3, p_ = s0 + 16 * (tau_) + t_; \
                _Pragma("unroll") for (int j = 0; j < 4; ++j) { const bf16* zp = F.Z + (rt_ + t_ - 3 + j) * NZ + 2048 + 64 * n + 16 * cg_; const bool ok_ = p_ - 3 + j >= 0; \
                    xc_n[2 * j] = ok_ ? *(const v4u*)zp : (v4u){0u, 0u, 0u, 0u}; xc_n[2 * j + 1] = ok_ ? *(const v4u*)(zp + 8) : (v4u){0u, 0u, 0u, 0u}; } } } while (0)
        LRU_FETCH(0);
        for (int tau = 0; tau < 8; ++tau) {
            const size_t rt = row0 + 16 * tau;
            float As[16], Us[16];
            v2u glv[4]; v4u lu[4], xcv[8];
#pragma unroll
            for (int mt = 0; mt < 4; ++mt) { lu[mt] = lu_n[mt]; glv[mt] = gl_n[mt]; }
#pragma unroll
            for (int q = 0; q < 8; ++q) xcv[q] = xc_n[q];
            if (tau < 7) LRU_FETCH(tau + 1);
            if (OUT) {
#pragma unroll
                for (int mt = 0; mt < 4; ++mt) { const unsigned wv[4] = {lu[mt].x, lu[mt].y, lu[mt].z, lu[mt].w};
#pragma unroll
                    for (int i = 0; i < 4; ++i) { As[4 * mt + i] = __builtin_amdgcn_exp2f(bflo(wv[i])); Us[4 * mt + i] = bfhi(wv[i]); } }
            } else {
                { const int t = lane >> 2, cg = lane & 3;
                  f32x4 o0 = *(const LAS f32x4*)(CW + 256 + 16 * cg), o1 = *(const LAS f32x4*)(CW + 256 + 16 * cg + 4), o2 = *(const LAS f32x4*)(CW + 256 + 16 * cg + 8), o3 = *(const LAS f32x4*)(CW + 256 + 16 * cg + 12);
#pragma unroll
                  for (int j = 0; j < 4; ++j) { {
                      const v4u x0 = xcv[2 * j], x1 = xcv[2 * j + 1];
                      const f32x4 w0 = *(const LAS f32x4*)(CW + j * 64 + 16 * cg), w1 = *(const LAS f32x4*)(CW + j * 64 + 16 * cg + 4), w2 = *(const LAS f32x4*)(CW + j * 64 + 16 * cg + 8), w3 = *(const LAS f32x4*)(CW + j * 64 + 16 * cg + 12);
                      o0 += w0 * (f32x4){bflo(x0.x), bfhi(x0.x), bflo(x0.y), bfhi(x0.y)}; o1 += w1 * (f32x4){bflo(x0.z), bfhi(x0.z), bflo(x0.w), bfhi(x0.w)};
                      o2 += w2 * (f32x4){bflo(x1.x), bfhi(x1.x), bflo(x1.y), bfhi(x1.y)}; o3 += w3 * (f32x4){bflo(x1.z), bfhi(x1.z), bflo(x1.w), bfhi(x1.w)}; } }
                  LAS f32x4* xo = (LAS f32x4*)(XC + t * 68 + 16 * cg); xo[0] = o0; xo[1] = o1; xo[2] = o2; xo[3] = o3; }
                bf16x8 fb[2];
#pragma unroll
                for (int ks = 0; ks < 2; ++ks) { const f32x4 v0 = *(const LAS f32x4*)(XC + lr * 68 + 32 * ks + 8 * lq), v1 = *(const LAS f32x4*)(XC + lr * 68 + 32 * ks + 8 * lq + 4);
                    v4u pb; pb.x = pg8::cvt_pk_bf16(v0.x, v0.y); pb.y = pg8::cvt_pk_bf16(v0.z, v0.w); pb.z = pg8::cvt_pk_bf16(v1.x, v1.y); pb.w = pg8::cvt_pk_bf16(v1.z, v1.w); fb[ks] = __builtin_bit_cast(bf16x8, pb); }
#pragma unroll
                for (int mt = 0; mt < 4; ++mt) {
                    const int e0 = 16 * mt + 4 * lq;
                    const f32x4 sp = *(const LAS f32x4*)(CN + 128 + e0), xc = *(const LAS f32x4*)(XC + lr * 68 + e0);
                    f32x4 R = *(const LAS f32x4*)(CN + e0), I = *(const LAS f32x4*)(CN + 64 + e0);
                    R = mma16(fa[mt][0], fb[0], R); R = mma16(fa[mt][1], fb[1], R); I = mma16(fx[mt][0], fb[0], I); I = mma16(fx[mt][1], fb[1], I);
                    unsigned wv[4];
#pragma unroll
                    for (int i = 0; i < 4; ++i) {
                        const float r = __builtin_amdgcn_rcpf(1.f + __builtin_amdgcn_exp2f(R[i])), ii = __builtin_amdgcn_rcpf(1.f + __builtin_amdgcn_exp2f(I[i]));
                        const float la = r * sp[i], a = __builtin_amdgcn_exp2f(la), uu = __builtin_amdgcn_sqrtf(fmaxf(fmaf(-a, a, 1.f), 0.f)) * (ii * xc[i]);
                        wv[i] = pg8::cvt_pk_bf16(la, uu);
                        As[4 * mt + i] = __builtin_amdgcn_exp2f(bflo(wv[i])); Us[4 * mt + i] = bfhi(wv[i]); }
                    *(v4u*)(LU + ((rt + lr) * 512 + 64 * n + e0) * 2) = (v4u){wv[0], wv[1], wv[2], wv[3]};
                }
            }
            LRU_SCAN_STEP(1); LRU_SCAN_STEP(2); LRU_SCAN_STEP(4); LRU_SCAN_STEP(8);
            float ssq = 0.f, yv[16], hc[16];
#pragma unroll
            for (int e = 0; e < 16; ++e) hc[e] = As[e] * hst[e] + Us[e];
            asm volatile("s_nop 1" : "+v"(hc[0]), "+v"(hc[1]), "+v"(hc[2]), "+v"(hc[3]), "+v"(hc[4]), "+v"(hc[5]), "+v"(hc[6]), "+v"(hc[7]));
            asm volatile("s_nop 1" : "+v"(hc[8]), "+v"(hc[9]), "+v"(hc[10]), "+v"(hc[11]), "+v"(hc[12]), "+v"(hc[13]), "+v"(hc[14]), "+v"(hc[15]));
#pragma unroll
            for (int e = 0; e < 16; ++e) hst[e] = row_bcast15_nn(hc[e]);
            if (!OUT) {
#pragma unroll
                for (int e = 0; e < 16; ++e) atot[e] *= row_bcast15_nn(As[e]);
            } else {
#pragma unroll
                for (int e = 0; e < 16; ++e) { const unsigned gw_ = (e & 2) ? glv[e >> 2].y : glv[e >> 2].x; const float y = hc[e] * gelu_tanh_f((e & 1) ? bfhi(gw_) : bflo(gw_)); yv[e] = y; ssq += y * y; }
            }
            if (OUT) {
                const int buf = tau & 1;
                ssq += __shfl_xor(ssq, 16); ssq += __shfl_xor(ssq, 32);
                if (lane < 16) red[(buf * 8 + n) * 16 + lane] = ssq;
                __syncthreads();
                float tot = 0.f;
#pragma unroll
                for (int ww = 0; ww < 8; ++ww) tot += red[(buf * 8 + ww) * 16 + lr];
                const float rstd = __builtin_amdgcn_rsqf(tot * (1.f / 512.f) + EPS);
#pragma unroll
                for (int mt = 0; mt < 4; ++mt) { const int e0 = 16 * mt + 4 * lq; const f32x4 gm = *(const LAS f32x4*)(CN + 192 + e0);
                    v2u o; o.x = pg8::cvt_pk_bf16(yv[4 * mt] * rstd * gm[0], yv[4 * mt + 1] * rstd * gm[1]); o.y = pg8::cvt_pk_bf16(yv[4 * mt + 2] * rstd * gm[2], yv[4 * mt + 3] * rstd * gm[3]);
                    *(v2u*)(F.HB + (rt + lr) * D + 512 + 64 * n + e0) = o; }
            }
        }
        if (!OUT && lr == 0) {
#pragma unroll
            for (int e = 0; e < 16; ++e) { const int o = ((b * 64 + sg) * 512 + 64 * n + 16 * (e >> 2) + 4 * lq + (e & 3)) * 2; F.CAR[o] = atot[e]; F.CAR[o + 1] = hst[e]; }
        }
    }
}

__device__ __forceinline__ void route_count(Frame& F) {
    LAS int* lcnt = (LAS int*)(F.lds + RING_OFF);
    asm volatile("s_waitcnt vmcnt(0)" ::: "memory");
    __syncthreads();
    for (int vb = F.vcu; vb < T / 128; vb += F.G) {
        if (F.tid < 32) lcnt[F.tid] = 0;
        __syncthreads();
        if (F.tid < 128) {
            const int tok = vb * 128 + F.tid;
            float lg[8];
#pragma unroll
            for (int j = 0; j < 8; ++j) lg[j] = __hip_atomic_load(F.RL + (size_t)tok * 8 + j, __ATOMIC_RELAXED, __HIP_MEMORY_SCOPE_AGENT);
            int i0 = 0; float v0 = lg[0];
#pragma unroll
            for (int j = 1; j < 8; ++j) if (lg[j] > v0) { v0 = lg[j]; i0 = j; }
            int i1 = -1; float v1 = -3.0e38f;
#pragma unroll
            for (int j = 0; j < 8; ++j) if (j != i0 && lg[j] > v1) { v1 = lg[j]; i1 = j; }
            const float ex = __expf(v1 - v0), p0 = 1.f / (1.f + ex), p1 = ex / (1.f + ex);
            F.TOPI[tok * 2] = i0; F.TOPI[tok * 2 + 1] = i1; F.TOPP[tok * 2] = p0; F.TOPP[tok * 2 + 1] = p1;
            __hip_atomic_fetch_add(&lcnt[i0], 1, __ATOMIC_RELAXED, __HIP_MEMORY_SCOPE_WORKGROUP); __hip_atomic_fetch_add(&lcnt[8 + i1], 1, __ATOMIC_RELAXED, __HIP_MEMORY_SCOPE_WORKGROUP);
            if (i1 == i0 + 1) __hip_atomic_fetch_add(&lcnt[16 + i0], 1, __ATOMIC_RELAXED, __HIP_MEMORY_SCOPE_WORKGROUP);
        }
        __syncthreads();
        if (F.tid < 32) F.CNT[vb * 32 + F.tid] = lcnt[F.tid];
        __syncthreads();
    }
}
__device__ __forceinline__ void route_place(Frame& F) {
    LAS int* ltot = (LAS int*)(F.lds + RING_OFF);
    LAS int* lbef = ltot + 32;
    LAS int* lf = lbef + 32;
    LAS int* loff = lf + 8;
    LAS int* ltp = loff + 16;
    LAS int* li0 = ltp + 16;
    LAS int* li1 = li0 + 128;
    LAS int* leA = li1 + 128;
    LAS int* leB = leA + 128;
    LAS int* lpos = leB + 128;
    LAS int* lred = lpos + 256;
    for (int vb = blockIdx.x; vb < T / 128; vb += F.G) {
        {
          const int c = F.tid & 31, gq = F.tid >> 5; int cv[16];
#pragma unroll
          for (int k = 0; k < 16; ++k) cv[k] = F.CNT[(gq * 16 + k) * 32 + c];
          int tot = 0, bef = 0;
#pragma unroll
          for (int k = 0; k < 16; ++k) { tot += cv[k]; bef += (gq * 16 + k < vb) ? cv[k] : 0; }
          lred[F.tid] = tot; lred[512 + F.tid] = bef;
          __syncthreads();
          if (F.tid < 32) { int t2 = 0, b2 = 0;
#pragma unroll
              for (int q = 0; q < 16; ++q) { t2 += lred[q * 32 + F.tid]; b2 += lred[512 + q * 32 + F.tid]; }
              ltot[F.tid] = t2; lbef[F.tid] = b2; } }
        if (F.tid < 128) { const int tok = vb * 128 + F.tid; li0[F.tid] = F.TOPI[tok * 2]; li1[F.tid] = F.TOPI[tok * 2 + 1]; }
        __syncthreads();
        if (F.tid == 0) {
            int f[8]; bool ok = true; int prev = 0;
            for (int e = 0; e < 7; ++e) { prev = ((ltot[e] & 255) + prev) & 255; f[e] = prev; ok = ok && (prev <= ltot[16 + e]); }
            f[7] = 0;
            if (!ok) for (int e = 0; e < 8; ++e) f[e] = 0;
            int baseA = 0, baseB = 0;
            for (int e = 0; e < 8; ++e) { lf[e] = f[e];
                const int fin = e ? f[e - 1] : 0, totA = ltot[e] - f[e] + fin, totB = ltot[e] + ltot[8 + e] - totA;
                const int outb = e < 7 ? (f[e] < lbef[16 + e] ? f[e] : lbef[16 + e]) : 0, inb = e ? (f[e - 1] < lbef[16 + e - 1] ? f[e - 1] : lbef[16 + e - 1]) : 0;
                const int befA = lbef[e] - outb + inb, befB = lbef[e] + lbef[8 + e] - befA;
                loff[e] = baseA + befA; loff[8 + e] = baseB + befB; ltp[e] = totA; ltp[8 + e] = totB; baseA += totA; baseB += totB; }
        }
        __syncthreads();
        if (F.tid < 128) { const int tt = F.tid, i0 = li0[tt], i1 = li1[tt]; bool sw = false;
            if (i1 == i0 + 1) { int q = 0; for (int j = 0; j < tt; ++j) q += (li0[j] == i0 && li1[j] == i1) ? 1 : 0; sw = (lbef[16 + i0] + q) < lf[i0]; }
            leA[tt] = sw ? i1 : i0; leB[tt] = sw ? i0 : i1; }
        __syncthreads();
        if (F.tid < 256) { const int s = F.tid >> 7, tt = F.tid & 127, tok = vb * 128 + tt; const LAS int* le = s ? leB : leA; const int e = le[tt]; int rank = 0;
            for (int j = 0; j < tt; ++j) rank += (le[j] == e) ? 1 : 0;
            const int pos = loff[s * 8 + e] + rank; const int which = (e == li0[tt]) ? 0 : 1;
            F.PERM[s * T + pos] = tok; F.PW[s * T + pos] = F.TOPP[tok * 2 + which]; lpos[s * 128 + tt] = pos; if (s == 1) F.POS1[tok] = pos; else F.POS0[tok] = pos; }
#if MOE_I8 && GATHER_OVERLAP
        __syncthreads();
#pragma unroll 1
        for (int h8 = 0; h8 < 2; ++h8) { v4u rw[8]; float sc[8];
#pragma unroll
            for (int j = 0; j < 8; ++j) { const int tok = vb * 128 + F.wave + NWAVES * (8 * h8 + j); rw[j] = *((const GAS v4u*)((const signed char*)F.HB8R + (size_t)tok * D) + F.lane); sc[j] = F.SA[tok]; }
#pragma unroll
            for (int j = 0; j < 8; ++j) { const int i = F.wave + NWAVES * (8 * h8 + j), pos0 = lpos[i], pos1 = (T + 256) + lpos[128 + i];
                *((GAS v4u*)((signed char*)F.ASORT + (size_t)pos0 * D) + F.lane) = rw[j]; *((GAS v4u*)((signed char*)F.ASORT + (size_t)pos1 * D) + F.lane) = rw[j];
                if (F.lane == 0) { F.SAS[pos0] = sc[j]; F.SAS[pos1] = sc[j]; } } }
#endif
        if (vb == 0 && F.tid < 2) { const int s = F.tid; int nt = 0, base = 0;
            for (int e = 0; e < NE; ++e) { const int tot = ltp[s * 8 + e];
                for (int i = 0; i * 256 < tot; ++i) { int* tp = F.TILES + (s * MAXTILES + nt) * 4; tp[0] = e; tp[1] = base + 256 * i; tp[2] = (tot - 256 * i) < 256 ? (tot - 256 * i) : 256; tp[3] = 0; ++nt; }
                base += tot; }
            F.NT[s] = nt; }
        __syncthreads();
    }
}
__device__ __forceinline__ void route_gather(Frame& F, int s, int wg, int nwg) {
    const int gw = wg * NWAVES + F.wave, NGW = nwg * NWAVES;
#if MOE_I8
    for (int p0 = gw; p0 < T; p0 += 8 * NGW) {
        int tok[8]; v4u rw[8]; float sc[8];
#pragma unroll
        for (int j = 0; j < 8; ++j) { const int pos = p0 + j * NGW; tok[j] = pos < T ? __builtin_amdgcn_readfirstlane(F.PERM[s * T + pos]) : -1; }
#pragma unroll
        for (int j = 0; j < 8; ++j) if (tok[j] >= 0) { rw[j] = *((const GAS v4u*)((const signed char*)F.HB8R + (size_t)tok[j] * D) + F.lane); sc[j] = F.SA[tok[j]]; }
#pragma unroll
        for (int j = 0; j < 8; ++j) if (tok[j] >= 0) { const int pos = p0 + j * NGW; *((GAS v4u*)((signed char*)F.ASORT + (size_t)pos * D) + F.lane) = rw[j]; if (F.lane == 0) F.SAS[pos] = sc[j]; }
    }
#else
    for (int pos = gw; pos < T; pos += NGW) { const int tok = F.PERM[s * T + pos];
        const GAS v4u* src = (const GAS v4u*)(F.HB + (size_t)tok * D) + F.lane; GAS v4u* dst = (GAS v4u*)(F.ASORT + (size_t)pos * D) + F.lane;
        dst[0] = src[0]; dst[64] = src[64]; }
#endif
}

constexpr int NPH = 26;
struct Args { const float* in[28]; float* out; unsigned char* ws; int ph_lo, ph_hi, dummy; };
__device__ __forceinline__ int opq_(int v) { asm volatile("" : "+s"(v)); return v; }
__global__ void __launch_bounds__(NWAVES * 64, 2) skel_fwd(Args args) {
    extern __shared__ __attribute__((aligned(16))) unsigned char lds[];
    Frame F;
    F.lds = (LAS unsigned char*)lds;
    F.MISC = (volatile LAS unsigned*)(F.lds + MISC_OFF);
    F.tid = threadIdx.x; F.lane = F.tid & 63; F.wave = __builtin_amdgcn_readfirstlane(F.tid >> 6); const int wave0_ = F.wave;
    F.G = gridDim.x; { const int bx = blockIdx.x; F.vcu = (F.G % 8 == 0) ? (bx % 8) * (F.G / 8) + bx / 8 : bx; }
    unsigned char* ws = args.ws;
    F.ctl = (gu32*)(ws + WS_CTL);
    F.x = args.in[0]; F.c = args.in[1]; F.w_ada = args.in[2]; F.b_ada = args.in[3]; F.g_norm_mix = args.in[4]; F.g_norm_ffn = args.in[5]; F.w_in = args.in[6]; F.w_conv_qk = args.in[7];
    F.b_conv_qk = args.in[8]; F.b_gates = args.in[9]; F.w_conv_lru = args.in[10]; F.b_conv_lru = args.in[11]; F.w_lru_a = args.in[12]; F.b_lru_a = args.in[13]; F.w_lru_x = args.in[14];
    F.b_lru_x = args.in[15]; F.lru_lambda = args.in[16]; F.g_mix_out = args.in[17]; F.w_out = args.in[18]; F.w_ff_gate = args.in[19]; F.w_ff_up = args.in[20]; F.w_ff_down = args.in[21];
    F.w_router = args.in[22]; F.b_router = args.in[23]; F.w_exp_gate = args.in[24]; F.w_exp_up = args.in[25]; F.w_exp_down = args.in[26]; F.g_final = args.in[27];
    F.out = args.out;
    F.MOD = (float*)(ws + WS_MOD); F.WG8 = (float*)(ws + WS_WG8); F.WR8 = (float*)(ws + WS_WR8); F.G8 = (float*)(ws + WS_G); F.RL = (float*)(ws + WS_RL);
    F.TOPI = (int*)(ws + WS_TOPI); F.TOPP = (float*)(ws + WS_TOPP); F.PERM = (int*)(ws + WS_PERM); F.PW = (float*)(ws + WS_PW); F.CNT = (int*)(ws + WS_CNT); F.TILES = (int*)(ws + WS_TILES); F.NT = (int*)(ws + WS_NT); F.POS1 = (int*)(ws + WS_CNT + 256 * KiB); F.POS0 = (int*)(ws + WS_CNT + 384 * KiB); F.D0A = (bf16*)(ws + WS_D0A); F.D0B = (bf16*)(ws + WS_D0B); F.D1 = (bf16*)(ws + WS_D1); F.PART = (float*)(ws + WS_PART); F.HB8F = (bf16*)(ws + WS_HRAW); F.HB8R = (bf16*)(ws + WS_Z);
    F.CAR = (float*)(ws + WS_CAR); F.HIN = (float*)(ws + WS_HIN); F.HRAW = (float*)(ws + WS_HRAW); F.CLOC = (float*)args.out; F.SA = (float*)(ws + WS_MOD + 512 * KiB); F.SAS = (float*)(ws + WS_MOD + 768 * KiB); F.SBF1 = (float*)(ws + WS_HIN + 576 * KiB); F.SBE1 = (float*)(ws + WS_HIN + 608 * KiB); F.SBIN = (float*)(ws + WS_HIN + 800 * KiB); F.SBINX = F.SBIN + 2 * NZ + 2048; F.MST = (float*)(ws + WS_HIN + 512 * KiB);
    F.WIN = (bf16*)(ws + WS_WIN); F.WOUT = (bf16*)(ws + WS_WOUT); F.WF1 = (bf16*)(ws + WS_WF1); F.WF2 = (bf16*)(ws + WS_WF2); F.WE1 = (bf16*)(ws + WS_WE1); F.WE2 = (bf16*)(ws + WS_WE2);
    F.HB = (bf16*)((unsigned char*)args.out + 64 * MiB); F.Z = (bf16*)(ws + WS_Z); F.HID = (bf16*)(ws + WS_Z); F.ASORT = (bf16*)(ws + WS_HRAW); F.XB = (bf16*)(ws + WS_HB);
    for (int u = F.tid; u < (LDS_BYTES - LDSCTL_OFF) / 4; u += NWAVES * 64) ((LAS unsigned*)(F.lds + LDSCTL_OFF))[u] = 0u;
    __syncthreads();
    XcdBarrier bar; bar.bar = (unsigned*)(F.ctl + CW_BAR); bar.x = 0; bar.st = nullptr; bar.lead = 0;
    if (!MK_PER_PHASE) bar = xcd_barrier_post((unsigned*)(F.ctl + CW_BAR), F.MISC + 8);
    if (!MK_PER_PHASE && threadIdx.x == 0) grp_barrier_post((unsigned*)(F.ctl + CW_BAR), blockIdx.x & 7u, bar.x);
    unsigned grp_gen = 0u; int gl_seen = 0;
    const int lo = args.ph_lo, hi = args.ph_hi;
#define IN(k) (lo <= (k) && (k) < hi)
#define REP(k) for (int rep_ = 0; rep_ < 1; ++rep_)
#ifdef SPLITMASK
#define RESBUF(k) ((args.dummy && (k) == hi - 1) ? (bf16*)F.out : F.XB)
#else
#define RESBUF(k) F.XB
#endif
#define REFRESH() do { int l_, w_ = wave0_; asm volatile("v_mbcnt_lo_u32_b32 %0, -1, 0\n\tv_mbcnt_hi_u32_b32 %0, -1, %0" : "=v"(l_)); asm volatile("" : "+s"(w_)); F.lane = l_; F.wave = w_; F.tid = 64 * w_ + l_; } while (0)
#ifndef SEAM_DUP
#define SEAM_DUP 0
#endif
#define STAGGER(u_) do { if (EPI_STAGGER) { const int g_ = (int)((blockIdx.x >> 3) & 3); for (int i_ = 0; i_ < g_ * (u_); ++i_) __builtin_amdgcn_s_sleep(64); } } while (0)
#define SEAM(k) do { if (!MK_PER_PHASE && IN(k) && IN((k) + 1)) { xcd_barrier(bar); if (SEAM_DUP) xcd_barrier(bar); gl_seen = 1; } } while (0)
#define SEAM_L(k) do { if (!MK_PER_PHASE && IN(k) && IN((k) + 1)) { if (LOCAL_SEAMS && gl_seen && F.G % 8 == 0 && F.G >= 8) grp_barrier(bar, blockIdx.x & 7u, (++grp_gen) * ((unsigned)F.G >> 3), F.MISC + 10); else { xcd_barrier(bar); gl_seen = 1; } } } while (0)

    if (IN(0)) REP(0) { REFRESH(); p0_prologue(F); quant_weights(F); } SEAM(0);

    for (int l = 0; l < 2; ++l) {
        const int pb = 1 + 9 * l;
        const float* mod = F.MOD + l * 4 * 6144;
        if (IN(pb)) REP(pb) { REFRESH();
            if (l == 0) norm_phase<true, true, IN_I8 != 0>(F, F.x, F.g_norm_mix, mod + 1024, mod, F.HB, F.WG8, F.b_gates, F.G8);
            else norm_phase<true, false, IN_I8 != 0>(F, F.XB, F.g_norm_mix + D, mod + 1024, mod, F.HB, F.WG8 + 8 * D, F.b_gates + 8, F.G8);
            if (blockIdx.x == 0) for (int i = F.tid; i < NZ; i += NWAVES * 64) F.SBINX[l * NZ + i] = F.SBIN[l * NZ + i] * ((i >= 1536 && i < 2048) ? -1.4426950408889634f : 1.f); }
        SEAM_L(pb);
#if IN_I8
        if (IN(pb + 1)) REP(pb + 1) { STAGGER(1); pg8::Gemm g{F.HB, (const bf16*)((const signed char*)F.WIN + (size_t)l * NZ * D), T, NZ, D / 2}; pg8::StaticOrder S; S.init(T, NZ, F.G, (int)blockIdx.x); pg8::EpiBf16q E{F.Z, NZ, F.SA, F.SBINX + l * NZ};
            pg8::gemm_phase<pg8::EpiBf16q, pg8::StaticOrder, PG8_ALIGN, PG8_SP2>(F.lds + RING_OFF, g, S, E, F.wave); }
#else
        if (IN(pb + 1)) REP(pb + 1) { pg8::Gemm g{F.HB, F.WIN + (size_t)l * NZ * D, T, NZ, D}; pg8::StaticOrder S; S.init(T, NZ, F.G, (int)blockIdx.x); pg8::EpiBf16 E{F.Z, NZ};
            pg8::gemm_phase<pg8::EpiBf16, pg8::StaticOrder, PG8_ALIGN, PG8_SP2>(F.lds + RING_OFF, g, S, E, F.wave); }
#endif
        SEAM(pb + 1);
        if (IN(pb + 2)) REP(pb + 2) { REFRESH();
            { const int alt_ = opq_(MIX_ALT ? (int)((blockIdx.x >> 3) & 1) : 0);
              if (alt_) { lru2<false>(F, l); __syncthreads(); REFRESH(); }
              for (int u = blockIdx.x; u < ML_UNITS; u += F.G) mlstm_unit2<false>(F, l, u);
              if (!alt_) { __syncthreads(); REFRESH(); lru2<false>(F, l); } }
        }
        SEAM(pb + 2);
        if (IN(pb + 3)) REP(pb + 3) { REFRESH();
            mlstm_scan(F);
            lru_scan(F); }
        SEAM(pb + 3);
        if (IN(pb + 4)) REP(pb + 4) { REFRESH();
            { const int alt_ = opq_(MIX_ALT ? (int)((blockIdx.x >> 3) & 1) : 0);
              if (alt_) { lru2<true>(F, l); __syncthreads(); REFRESH(); }
              for (int u = blockIdx.x; u < ML_UNITS; u += F.G) mlstm_unit2<true>(F, l, u);
              if (!alt_) { __syncthreads(); REFRESH(); lru2<true>(F, l); } }
        }
        SEAM(pb + 4);
        if (IN(pb + 5)) REP(pb + 5) { pg8::Gemm g{F.HB, F.WOUT + (size_t)l * D * D, T, D, D}; pg8::StaticOrder S; S.init(T, D, F.G, (int)blockIdx.x); Gemm2Epi E; E.x = RESBUF(pb + 5); E.gate = mod + 2048; E.osc = 1.f;
            pg8::gemm_phase<Gemm2Epi, pg8::StaticOrder, PG8_ALIGN, PG8_SP2>(F.lds + RING_OFF, g, S, E, F.wave); }
        SEAM_L(pb + 5);
        if (l == 0) {
            if (IN(7)) REP(7) { REFRESH(); norm_phase<false, false, true>(F, F.XB, F.g_norm_ffn, mod + 4096, mod + 3072, F.HB8F, nullptr, nullptr, nullptr); }
            SEAM_L(7);
            if (IN(8)) REP(8) { STAGGER(1); pg8::Gemm g{F.HB8F, F.WF1, T, 2 * FF, D / 2}; pg8::StaticOrder S; S.init(T, 2 * FF, F.G, (int)blockIdx.x); DenseUpEpi E{F.HID, FF, F.SA, F.SBF1, F8_HS};
                pg8::gemm_phase<DenseUpEpi, pg8::StaticOrder, PG8_ALIGN, PG8_SP2>(F.lds + RING_OFF, g, S, E, F.wave); }
            SEAM_L(8);
            if (IN(9)) REP(9) { pg8::Gemm g{F.HID, F.WF2, T, D, FP8_DENSE ? FF / 2 : FF}; pg8::StaticOrder S; S.init(T, D, F.G, (int)blockIdx.x); DenseDownEpi E; E.x = RESBUF(9); E.gate = mod + 5120; E.osc = FP8_DENSE ? 1.f / (F8_HS * F8_WS) : 1.f;
                pg8::gemm_phase<DenseDownEpi, pg8::StaticOrder, PG8_ALIGN, PG8_SP2>(F.lds + RING_OFF, g, S, E, F.wave); }
            SEAM(9);
        } else {
            if (IN(16)) REP(16) { REFRESH(); norm_phase<true, false, MOE_I8 != 0>(F, F.XB, F.g_norm_ffn + D, mod + 4096, mod + 3072, F.HB8R, F.WR8, F.b_router, F.RL); }
            if (MK_PER_PHASE || F.G != T / 128) SEAM(16);
            if (IN(17)) REP(17) { REFRESH(); route_count(F); }
            SEAM(17);
            if (IN(18)) REP(18) { REFRESH(); route_place(F); }
            SEAM(18);
            for (int s = 0; s < 2; ++s) {
                const int qb = 19 + 3 * s;
                if (IN(qb)) REP(qb) { REFRESH(); if (!(MOE_I8 && GATHER_OVERLAP)) { if (s == 0 || !GATHER_OVERLAP) route_gather(F, s, (int)blockIdx.x, F.G); } }
                if (!(MOE_I8 && GATHER_OVERLAP) && (s == 0 || !GATHER_OVERLAP)) SEAM(qb);
                if (IN(qb + 1)) REP(qb + 1) { STAGGER(1); const int nT = __builtin_amdgcn_readfirstlane(F.NT[s]);
#if MOE_I8
                    pg8::Gemm g{F.ASORT + (size_t)s * (T + 256) * (D / 2), F.WE1, T, 2 * FF, D / 2}; pg8::MoeOrder S; S.init(F.TILES + s * MAXTILES * 4, nT, 2 * FF / 256, F.G, (int)blockIdx.x, F.lds + RING_OFF, F.wave); MoeUpEpi E{F.HID, FF, F.SAS + s * (T + 256), F.SBE1, F8_HS};
                    pg8::gemm_phase<MoeUpEpi, pg8::MoeOrder, PG8_ALIGN, PG8_SP2>(F.lds + RING_OFF, g, S, E, F.wave); }
#else
                    pg8::Gemm g{F.ASORT, F.WE1, T, 2 * FF, D}; pg8::MoeOrder S; S.init(F.TILES + s * MAXTILES * 4, nT, 2 * FF / 256, F.G, (int)blockIdx.x, F.lds + RING_OFF, F.wave); pg8::EpiSwiGLU E{F.HID, FF};
                    pg8::gemm_phase<pg8::EpiSwiGLU, pg8::MoeOrder, PG8_ALIGN, PG8_SP2>(F.lds + RING_OFF, g, S, E, F.wave); }
#endif
                SEAM(qb + 1);
                if (IN(qb + 2)) REP(qb + 2) { const int nT = __builtin_amdgcn_readfirstlane(F.NT[s]);
                    pg8::Gemm g{F.HID, F.WE2, T, D, FP8_MOE ? FF / 2 : FF}; pg8::EpiDeltaF8 E; E.d0 = (signed char*)(s ? F.D1 : F.D0A); E.pw = F.PW + s * T; E.osc = 1.f / (F8_HS * F8_WS); E.dsc = F8_DS;

                    const bool tail_ = (s == 1 && MOE_TAIL && F.G == 256 && nT > 128);
                    { pg8::MoeOrder S; S.init(F.TILES + s * MAXTILES * 4, tail_ ? 128 : nT, D / 256, F.G, (int)blockIdx.x, F.lds + RING_OFF, F.wave);
                      pg8::gemm_phase<pg8::EpiDeltaF8, pg8::MoeOrder, PG8_ALIGN, PG8_SP2>(F.lds + RING_OFF, g, S, E, F.wave); }
                    if (tail_) {
                        int c2 = (int)blockIdx.x; asm volatile("" : "+s"(c2));
                        pg8::MoeSliceOrder S2; S2.init(F.TILES + s * MAXTILES * 4, nT, D / 256, F.G, c2, MOE_DOWN_KT, PART_SLOTS); MoePartEpi E2; E2.part = F.PART;
                        pg8::gemm_phase<MoePartEpi, pg8::MoeSliceOrder, PG8_ALIGN, PG8_SP2>(F.lds + RING_OFF, g, S2, E2, F.wave); }
                }
                SEAM(qb + 2);
            }
        }
    }
    if (IN(25)) REP(25) { REFRESH(); final_norm(F); }
#undef IN
#undef SEAM
}

extern "C" void kernel_launch(void* const* d_in, const int* in_sizes, int n_in, void* d_out, int out_size, void* d_ws, size_t ws_size, hipStream_t stream) {
    static int grid = 0;
    if (grid == 0) {
        if (n_in != 28 || in_sizes[0] != T * D || out_size != T * D || ws_size < WS_END) { fprintf(stderr, "kernel_launch: unexpected problem: n_in %d, in0 %d, out %d, ws %zu (need %zu); nothing launched\n", n_in, n_in > 0 ? in_sizes[0] : -1, out_size, ws_size, (size_t)WS_END); grid = -1; return; }
        int dev = 0, cus = 0, per_cu = 0;
        if (hipGetDevice(&dev) != hipSuccess || hipDeviceGetAttribute(&cus, hipDeviceAttributeMultiprocessorCount, dev) != hipSuccess) { fprintf(stderr, "kernel_launch: device query failed\n"); grid = -1; return; }
        if (hipFuncSetAttribute((const void*)skel_fwd, hipFuncAttributeMaxDynamicSharedMemorySize, LDS_BYTES) != hipSuccess) { fprintf(stderr, "kernel_launch: hipFuncSetAttribute failed\n"); grid = -1; return; }
        if (hipOccupancyMaxActiveBlocksPerMultiprocessor(&per_cu, (const void*)skel_fwd, NWAVES * 64, LDS_BYTES) != hipSuccess || per_cu < 1) fprintf(stderr, "kernel_launch: note: occupancy query reports %d workgroups per CU\n", per_cu);
        (void)hipGetLastError();
        grid = cus;
    }
    if (grid < 0) return;
    if (hipMemsetAsync((char*)d_ws + WS_CTL, 0, CTL_ZERO_BYTES, stream) != hipSuccess) { fprintf(stderr, "kernel_launch: memset failed\n"); return; }
    Args a{};
    for (int i = 0; i < 28; ++i) a.in[i] = (const float*)d_in[i];
    a.out = (float*)d_out; a.ws = (unsigned char*)d_ws;
#if MK_PER_PHASE
    for (int ph = 0; ph < NPH; ++ph) { a.ph_lo = ph; a.ph_hi = ph + 1; hipLaunchKernelGGL(skel_fwd, dim3(grid), dim3(NWAVES * 64), LDS_BYTES, stream, a); }
#else
#ifdef SPLITMASK
    { int lo = 0;
      for (int k = 0; k < NPH; ++k) if (((unsigned)SPLITMASK >> k) & 1u) { a.ph_lo = lo; a.ph_hi = k + 1; a.dummy = SPLITDUP; hipLaunchKernelGGL(skel_fwd, dim3(grid), dim3(NWAVES * 64), LDS_BYTES, stream, a);
          hipMemsetAsync((char*)d_ws + WS_CTL, 0, CTL_ZERO_BYTES, stream); lo = SPLITDUP ? k : k + 1; }
      a.ph_lo = lo; a.ph_hi = NPH; a.dummy = 0; hipLaunchKernelGGL(skel_fwd, dim3(grid), dim3(NWAVES * 64), LDS_BYTES, stream, a); }
#else
    a.ph_lo = 0; a.ph_hi = NPH; hipLaunchKernelGGL(skel_fwd, dim3(grid), dim3(NWAVES * 64), LDS_BYTES, stream, a);
#endif
#endif
    const hipError_t le = hipPeekAtLastError();
    if (le != hipSuccess) fprintf(stderr, "kernel_launch: launch failed: %s\n", hipGetErrorName(le));
}
```

```cpp
#include <hip/hip_runtime.h>
#include <cstdio>
#include <cstdint>
namespace pg8 {
#define PG8_LAS __attribute__((address_space(3)))
typedef unsigned short bf16_t;
typedef short bf16x8 __attribute__((ext_vector_type(8)));
typedef float f32x4 __attribute__((ext_vector_type(4)));
typedef float f32x2 __attribute__((ext_vector_type(2)));
typedef unsigned u32x4 __attribute__((ext_vector_type(4)));
typedef unsigned u32x2 __attribute__((ext_vector_type(2)));
constexpr int PG8_SPARE = 132096;
constexpr int BM = 256, BK = 64, HALF = 128, HTB = HALF * BK * 2  , STAGE_BYTES = 8 * HTB, NXCD = 8, WGM = 8;

__host__ __device__ __forceinline__ int lds_byte(int r, int c) { const int st = (r >> 4) * 2 + (c >> 5), rr = r & 15, cc = c & 31, ob = rr * 64 + cc * 2; return st * 1024 + (ob ^ (((ob >> 9) & 1) << 5)); }
__host__ __device__ __forceinline__ void stage_rc(int b, int& R, int& C) { const int st = b / 1024, sb = b % 1024, swz = sb ^ (((sb >> 9) & 1) << 5); R = (st >> 1) * 16 + swz / 64; C = (st & 1) * 32 + (swz % 64) / 2; }
__host__ __device__ __forceinline__ int perm32(int rho) { const int n = rho >> 4, i = rho & 15; return 8 * (i >> 2) + 4 * n + (i & 3); }

struct Unit { int pm, pn, arow, brow, orow, nvalid, kt0, nkt, slice, wt; };
struct Gemm { const bf16_t* A; const bf16_t* Bt; int M, N, K; };

__device__ __forceinline__ int xcd_remap(int wgid, int nwg) { const int q = nwg / NXCD, r = nwg % NXCD, xcd = wgid % NXCD, off = wgid / NXCD; return (xcd < r ? xcd * (q + 1) : r * (q + 1) + (xcd - r) * q) + off; }

struct StaticOrder {
    static constexpr bool FULL = true;
    int nM, nN, nwg, G, c;
    __device__ __forceinline__ void init(int M, int N, int G_, int c_) { nM = M / BM; nN = N / BM; nwg = nM * nN; G = G_; c = c_; }
    __device__ __forceinline__ bool next(int i, Unit& u) const {
        const long L = (long)i * G + c; if (L >= nwg) return false;
        const int wgid = xcd_remap((int)L, nwg);
        const int nig = WGM * nN, gid = wgid / nig, fm = gid * WGM, gsz = (nM - fm) < WGM ? (nM - fm) : WGM;
        u.pm = fm + ((wgid % nig) % gsz); u.pn = (wgid % nig) / gsz; u.arow = u.pm * BM; u.brow = u.pn * BM; u.orow = u.pm * BM; u.nvalid = BM; u.kt0 = 0; u.nkt = 0; u.slice = -1; u.wt = 0; return true;
    }
    __device__ __forceinline__ void a_ready(const Unit&) const {}
    __device__ __forceinline__ void done(const Unit&) const {}
};
struct MoeOrder {
    static constexpr bool FULL = false;
    static constexpr int TAB_OFF = 131584, MAXU = 16;
    const int* tiles; int nT, nN, nwg, G, c; PG8_LAS int* tab;
    __device__ __forceinline__ void init(const int* tiles_, int nT_, int nN_, int G_, int c_, PG8_LAS unsigned char* ldsbase, int wave) { tiles = tiles_; nT = nT_; nN = nN_; nwg = nT * nN; G = G_; c = c_;
        tab = (PG8_LAS int*)(ldsbase + TAB_OFF);
        int ln; asm volatile("v_mbcnt_lo_u32_b32 %0, -1, 0\n\tv_mbcnt_hi_u32_b32 %0, -1, %0" : "=v"(ln));
        __syncthreads();
        if (wave == 0 && ln < MAXU) { const long L = (long)ln * G + c; int d0 = -1, d1 = 0, d2 = 0, d3 = 0;
            if (L < nwg) { const int wgid = xcd_remap((int)L, nwg);
                const int nig = WGM * nN, gid = wgid / nig, fm = gid * WGM, gsz = (nT - fm) < WGM ? (nT - fm) : WGM;
                const int tile = fm + ((wgid % nig) % gsz), pn = (wgid % nig) / gsz;
                d0 = tiles[tile * 4]; d1 = tiles[tile * 4 + 1]; d2 = tiles[tile * 4 + 2]; d3 = tile * 32 + pn; }
            tab[ln * 4] = d0; tab[ln * 4 + 1] = d1; tab[ln * 4 + 2] = d2; tab[ln * 4 + 3] = d3; }
        __syncthreads(); }
    __device__ __forceinline__ bool next(int i, Unit& u) const {
        if (i >= MAXU) return false;
        const int e = __builtin_amdgcn_readfirstlane(tab[i * 4]), rs = __builtin_amdgcn_readfirstlane(tab[i * 4 + 1]), nv = __builtin_amdgcn_readfirstlane(tab[i * 4 + 2]), tp = __builtin_amdgcn_readfirstlane(tab[i * 4 + 3]);
        if (e < 0) return false;
        const int tile = tp >> 5, pn = tp & 31;
        u.pm = tile; u.pn = pn; u.arow = rs; u.brow = e * (nN * BM) + pn * BM; u.orow = rs; u.nvalid = nv; u.kt0 = 0; u.nkt = 0; u.slice = -1; u.wt = 0; return true;
    }
    __device__ __forceinline__ void a_ready(const Unit&) const {}
    __device__ __forceinline__ void done(const Unit&) const {}
};

typedef int i32x4 __attribute__((ext_vector_type(4)));
__device__ __forceinline__ f32x4 mma_acc(bf16x8 b, bf16x8 a, f32x4 c) { return __builtin_amdgcn_mfma_f32_16x16x32_bf16(b, a, c, 0, 0, 0); }
typedef int i32x8 __attribute__((ext_vector_type(8)));
__device__ __forceinline__ f32x4 mma_f8(bf16x8 b0, bf16x8 b1, bf16x8 a0, bf16x8 a1, f32x4 c) {
    const i32x4 bl = __builtin_bit_cast(i32x4, b0), bh = __builtin_bit_cast(i32x4, b1), al = __builtin_bit_cast(i32x4, a0), ah = __builtin_bit_cast(i32x4, a1);
    const i32x8 B = {bl[0], bl[1], bl[2], bl[3], bh[0], bh[1], bh[2], bh[3]}, A = {al[0], al[1], al[2], al[3], ah[0], ah[1], ah[2], ah[3]};
    asm volatile("v_mfma_f32_16x16x128_f8f6f4 %0, %1, %2, %0" : "+v"(c) : "v"(B), "v"(A));
    return c;
}
__device__ __forceinline__ unsigned pack_fp8x4n(float a, float b, float c, float d) {
    int p = __builtin_amdgcn_cvt_pk_fp8_f32(__builtin_amdgcn_fmed3f(a, -448.f, 448.f), __builtin_amdgcn_fmed3f(b, -448.f, 448.f), 0, false);
    p = __builtin_amdgcn_cvt_pk_fp8_f32(__builtin_amdgcn_fmed3f(c, -448.f, 448.f), __builtin_amdgcn_fmed3f(d, -448.f, 448.f), p, true); return (unsigned)p;
}
template <class E, class = void> struct epi_nst { static constexpr int value = 0; };
template <class E> struct epi_nst<E, decltype((void)E::NST)> { static constexpr int value = E::NST; };
template <class E, class = void> struct epi_fp8 { static constexpr bool value = false; };
template <class E> struct epi_fp8<E, decltype((void)E::FP8)> { static constexpr bool value = E::FP8; };
__device__ __forceinline__ unsigned pack_fp8x4(float a, float b, float c, float d, float s) {
    const float a_ = __builtin_amdgcn_fmed3f(a * s, -448.f, 448.f), b_ = __builtin_amdgcn_fmed3f(b * s, -448.f, 448.f), c_ = __builtin_amdgcn_fmed3f(c * s, -448.f, 448.f), d_ = __builtin_amdgcn_fmed3f(d * s, -448.f, 448.f);
    int p = __builtin_amdgcn_cvt_pk_fp8_f32(a_, b_, 0, false); p = __builtin_amdgcn_cvt_pk_fp8_f32(c_, d_, p, true); return (unsigned)p;
}
__device__ __forceinline__ i32x4 mma_acc(bf16x8 b, bf16x8 a, i32x4 c) { return __builtin_amdgcn_mfma_i32_16x16x64_i8(__builtin_bit_cast(i32x4, b), __builtin_bit_cast(i32x4, a), c, 0, 0, 0); }
__device__ __forceinline__ int tail_slices(int R, int G, int ntK, int cap) { int S = G / R; S = S < ntK / 4 ? S : ntK / 4; S = S < cap / R ? S : cap / R; return S; }
struct MoeSliceOrder {
    static constexpr bool FULL = false;
    const int* tiles; int nN, c, tL, tkt0, tnkt;
    __device__ __forceinline__ void init(const int* tiles_, int nT, int nN_, int G, int c_, int ntK, int cap) { tiles = tiles_; nN = nN_; c = c_;
        const int R = nT * nN - 2 * G, S = R > 0 ? tail_slices(R, G, ntK, cap) : 0; tL = -1; tkt0 = 0; tnkt = 0;
        if (R > 0 && c < R * S) { const int e = c / S, k = c % S, pairs = ntK / 2, p0 = pairs * k / S, p1 = pairs * (k + 1) / S;
            tL = __builtin_amdgcn_readfirstlane(2 * G + e); tkt0 = __builtin_amdgcn_readfirstlane(2 * p0); tnkt = __builtin_amdgcn_readfirstlane(2 * (p1 - p0)); } }
    __device__ __forceinline__ bool next(int i, Unit& u) const {
        if (i > 0 || tL < 0) return false;
        const int tile = __builtin_amdgcn_readfirstlane(tL / nN), pn = __builtin_amdgcn_readfirstlane(tL % nN);
        const int e = __builtin_amdgcn_readfirstlane(tiles[tile * 4]), rs = __builtin_amdgcn_readfirstlane(tiles[tile * 4 + 1]), nv = __builtin_amdgcn_readfirstlane(tiles[tile * 4 + 2]);
        u.pm = tile; u.pn = pn; u.arow = rs; u.brow = e * (nN * BM) + pn * BM; u.orow = rs; u.nvalid = nv; u.kt0 = tkt0; u.nkt = tnkt; u.slice = c; u.wt = 0; return true;
    }
    __device__ __forceinline__ void a_ready(const Unit&) const {}
    __device__ __forceinline__ void done(const Unit&) const {}
};
__device__ __forceinline__ unsigned cvt_pk_bf16(float lo, float hi) { unsigned r; asm volatile("v_cvt_pk_bf16_f32 %0, %1, %2" : "=v"(r) : "v"(lo), "v"(hi)); return r; }

#ifndef LAST_WT
#define LAST_WT 1
#endif
#ifndef WT_STORES
#define WT_STORES 0
#endif
__device__ __forceinline__ void st16(void* p, u32x4 v) {
#if WT_STORES
    asm volatile("global_store_dwordx4 %0, %1, off nt\n\ts_nop 1" :: "v"(p), "v"(v) : "memory");
#else
    *(u32x4*)p = v;
#ifdef PROBE_ST2
    asm volatile("global_store_dwordx4 %0, %1, off" :: "v"(p), "v"(v) : "memory");
#endif
#endif
}
__device__ __forceinline__ void st16w(void* p, u32x4 v, int wt) { if (wt) asm volatile("global_store_dwordx4 %0, %1, off sc0 sc1" :: "v"(p), "v"(v) : "memory"); else *(u32x4*)p = v; }
__device__ __forceinline__ void st8w(void* p, u32x2 v, int wt) {
    asm volatile("v_readfirstlane_b32 vcc_lo, %2\n\ts_nop 3\n\ts_cmp_eq_u32 vcc_lo, 0\n\ts_cbranch_scc1 3\n\tglobal_store_dwordx2 %0, %1, off sc0 sc1\n\ts_branch 2\n\tglobal_store_dwordx2 %0, %1, off" :: "v"(p), "v"(v), "v"(wt) : "memory", "scc", "vcc"); }
struct EpiBf16 {
    static constexpr bool PERM = true, AFTER_DRAIN = false, PREFETCH = false, LDSPRE = false; typedef f32x4 acc_t; struct Pre {};
    bf16_t* O; int ldc;
    __device__ __forceinline__ void operator()(const f32x4 (&acc)[2][2][4][2], const Unit& u, int wr, int wc, int fr, int fq) const {
        const int row0 = u.orow + wr * 64 + fr, col0 = u.pn * BM + wc * 32 + 8 * fq;
#pragma unroll
        for (int ai = 0; ai < 2; ++ai)
#pragma unroll
            for (int m = 0; m < 4; ++m) { bf16_t* rowp = O + (size_t)(row0 + ai * HALF + m * 16) * ldc + col0;
#pragma unroll
                for (int bj = 0; bj < 2; ++bj) { const f32x4 v0 = acc[ai][bj][m][0], v1 = acc[ai][bj][m][1];
                    u32x4 w; w.x = cvt_pk_bf16(v0[0], v0[1]); w.y = cvt_pk_bf16(v0[2], v0[3]); w.z = cvt_pk_bf16(v1[0], v1[1]); w.w = cvt_pk_bf16(v1[2], v1[3]);
                    st16(rowp + bj * HALF, w); } }
    }
};
__device__ __forceinline__ float bf_lo(unsigned w) { return __builtin_bit_cast(float, w << 16); }
__device__ __forceinline__ float bf_hi(unsigned w) { return __builtin_bit_cast(float, w & 0xffff0000u); }
struct EpiRes {
    static constexpr bool PERM = true, AFTER_DRAIN = false, PREFETCH = false, LDSPRE = false; typedef f32x4 acc_t; struct Pre {};
    bf16_t* x; const float* gate; float osc;
    __device__ __forceinline__ void operator()(const f32x4 (&acc)[2][2][4][2], const Unit& u, int wr, int wc, int fr, int fq) const {
        const int row0 = u.orow + wr * 64 + fr, col0 = u.pn * BM + wc * 32 + 8 * fq;
        const float* gp = gate + (size_t)(u.orow >> 13) * 6144 + col0;
        f32x4 gv[2][2];
#pragma unroll
        for (int bj = 0; bj < 2; ++bj)
#pragma unroll
            for (int n = 0; n < 2; ++n) gv[bj][n] = *(const f32x4*)(gp + bj * HALF + 4 * n) * osc;
#pragma unroll
        for (int ai = 0; ai < 2; ++ai) {
            u32x4 xin[4][2];
#pragma unroll
            for (int m = 0; m < 4; ++m)
#pragma unroll
                for (int bj = 0; bj < 2; ++bj) xin[m][bj] = *(const u32x4*)(x + (size_t)(row0 + ai * HALF + m * 16) * 1024 + col0 + bj * HALF);
#pragma unroll
            for (int m = 0; m < 4; ++m) { bf16_t* rowp = x + (size_t)(row0 + ai * HALF + m * 16) * 1024 + col0;
#pragma unroll
                for (int bj = 0; bj < 2; ++bj) { const u32x4 xv = xin[m][bj];
                    const f32x4 v0 = (f32x4){bf_lo(xv.x), bf_hi(xv.x), bf_lo(xv.y), bf_hi(xv.y)} + gv[bj][0] * acc[ai][bj][m][0], v1 = (f32x4){bf_lo(xv.z), bf_hi(xv.z), bf_lo(xv.w), bf_hi(xv.w)} + gv[bj][1] * acc[ai][bj][m][1];
                    u32x4 w; w.x = cvt_pk_bf16(v0[0], v0[1]); w.y = cvt_pk_bf16(v0[2], v0[3]); w.z = cvt_pk_bf16(v1[0], v1[1]); w.w = cvt_pk_bf16(v1[2], v1[3]);
                    st16(rowp + bj * HALF, w); } } }
    }
};
__device__ __forceinline__ float silu_f(float v) { return v * __builtin_amdgcn_rcpf(1.f + __expf(-v)); }
struct EpiSwiGLU {
    static constexpr bool PERM = true, AFTER_DRAIN = false, PREFETCH = false, LDSPRE = false; typedef f32x4 acc_t; struct Pre {};
    bf16_t* H; int ldh;
    __device__ __forceinline__ void operator()(const f32x4 (&acc)[2][2][4][2], const Unit& u, int wr, int wc, int fr, int fq) const {
        const int rl0 = wr * 64 + fr, col0 = u.pn * HALF + wc * 32 + 8 * fq;
#pragma unroll
        for (int ai = 0; ai < 2; ++ai)
#pragma unroll
            for (int m = 0; m < 4; ++m) { const int rl = rl0 + ai * HALF + m * 16;
                const f32x4 g0 = acc[ai][0][m][0], g1 = acc[ai][0][m][1], u0 = acc[ai][1][m][0], u1 = acc[ai][1][m][1];
                u32x4 w; w.x = cvt_pk_bf16(silu_f(g0[0]) * u0[0], silu_f(g0[1]) * u0[1]); w.y = cvt_pk_bf16(silu_f(g0[2]) * u0[2], silu_f(g0[3]) * u0[3]);
                w.z = cvt_pk_bf16(silu_f(g1[0]) * u1[0], silu_f(g1[1]) * u1[1]); w.w = cvt_pk_bf16(silu_f(g1[2]) * u1[2], silu_f(g1[3]) * u1[3]);
                if (rl < u.nvalid) st16(H + (size_t)(u.orow + rl) * ldh + col0, w); }
    }
};
struct EpiBf16q {
    static constexpr bool PERM = true, AFTER_DRAIN = false, PREFETCH = false, LDSPRE = true; typedef i32x4 acc_t; struct Pre {}; static constexpr int NST = 16;
    bf16_t* O; int ldc; const float* sa; const float* sb;
    __device__ __forceinline__ void lds_prefetch(PG8_LAS unsigned char* sp, const Unit& u, int wid, int lane) const {
        const int ln = (int)__builtin_amdgcn_mbcnt_hi(~0u, __builtin_amdgcn_mbcnt_lo(~0u, 0u));
        const float* src = (wid < 4 ? sa + u.orow : sb + u.brow - 256) + 64 * wid + ln;
        __builtin_amdgcn_global_load_lds((const unsigned*)src, (PG8_LAS unsigned*)(sp + 256 * wid), 4, 0, 0);
    }
    __device__ __forceinline__ void operator()(const i32x4 (&acc)[2][2][4][2], const Unit& u, int wr, int wc, int fr, int fq, PG8_LAS unsigned char* spb) const {
        const PG8_LAS float* SAl = (const PG8_LAS float*)spb; const PG8_LAS float* SBl = SAl + 256 + wc * 32 + 8 * fq;
        const int row0 = u.orow + wr * 64 + fr, col0 = u.pn * BM + wc * 32 + 8 * fq;
        f32x4 sv[2][2];
#pragma unroll
        for (int bj = 0; bj < 2; ++bj) { sv[bj][0] = *(const PG8_LAS f32x4*)(SBl + bj * HALF); sv[bj][1] = *(const PG8_LAS f32x4*)(SBl + bj * HALF + 4); }
#pragma unroll
        for (int ai = 0; ai < 2; ++ai)
#pragma unroll
            for (int m = 0; m < 4; ++m) { const int row = row0 + ai * HALF + m * 16; const float s = SAl[wr * 64 + fr + ai * HALF + m * 16]; bf16_t* rowp = O + (size_t)row * ldc + col0;
#pragma unroll
                for (int bj = 0; bj < 2; ++bj) { const f32x4 v0 = __builtin_convertvector(acc[ai][bj][m][0], f32x4) * sv[bj][0] * s, v1 = __builtin_convertvector(acc[ai][bj][m][1], f32x4) * sv[bj][1] * s;
                    u32x4 w; w.x = cvt_pk_bf16(v0[0], v0[1]); w.y = cvt_pk_bf16(v0[2], v0[3]); w.z = cvt_pk_bf16(v1[0], v1[1]); w.w = cvt_pk_bf16(v1[2], v1[3]);
                    st16(rowp + bj * HALF, w); } }
    }
};
__device__ __forceinline__ float sgl_f(float gp, float up) { return (gp * up) * __builtin_amdgcn_rcpf(1.f + __builtin_amdgcn_exp2f(gp)); }
template <bool F8OUT> struct EpiSwiGLUqT {
    static constexpr bool PERM = true, AFTER_DRAIN = false, PREFETCH = false, LDSPRE = true; typedef i32x4 acc_t; struct Pre {}; static constexpr int NST = 8;
    bf16_t* H; int ldh; const float* sa; const float* sb; float emu;
    __device__ __forceinline__ void lds_prefetch(PG8_LAS unsigned char* sp, const Unit& u, int wid, int lane) const {
        const int ln = (int)__builtin_amdgcn_mbcnt_hi(~0u, __builtin_amdgcn_mbcnt_lo(~0u, 0u));
        const float* src = (wid < 4 ? sa + u.orow : sb + u.brow - 256) + 64 * wid + ln;
        __builtin_amdgcn_global_load_lds((const unsigned*)src, (PG8_LAS unsigned*)(sp + 256 * wid), 4, 0, 0);
    }
    __device__ __forceinline__ void operator()(const i32x4 (&acc)[2][2][4][2], const Unit& u, int wr, int wc, int fr, int fq, PG8_LAS unsigned char* spb) const {
        const PG8_LAS float* SAl = (const PG8_LAS float*)spb; const PG8_LAS float* SBl = SAl + 256 + wc * 32 + 8 * fq;
        const int rl0 = wr * 64 + fr, col0 = u.pn * HALF + wc * 32 + 8 * fq;
#pragma unroll
        for (int ai = 0; ai < 2; ++ai)
#pragma unroll
            for (int m = 0; m < 4; ++m) { const int rl = rl0 + ai * HALF + m * 16; const float s = SAl[rl];
                const f32x4 sg0 = *(const PG8_LAS f32x4*)SBl, sg1 = *(const PG8_LAS f32x4*)(SBl + 4), su0 = *(const PG8_LAS f32x4*)(SBl + HALF), su1 = *(const PG8_LAS f32x4*)(SBl + HALF + 4);
                const f32x4 g0 = __builtin_convertvector(acc[ai][0][m][0], f32x4) * sg0 * s, g1 = __builtin_convertvector(acc[ai][0][m][1], f32x4) * sg1 * s;
                const f32x4 u0 = __builtin_convertvector(acc[ai][1][m][0], f32x4) * su0 * s, u1 = __builtin_convertvector(acc[ai][1][m][1], f32x4) * su1 * s;
                float r_[8];
                { const f32x2 gp[4] = {__builtin_shufflevector(g0, g0, 0, 1), __builtin_shufflevector(g0, g0, 2, 3), __builtin_shufflevector(g1, g1, 0, 1), __builtin_shufflevector(g1, g1, 2, 3)};
                  const f32x2 up[4] = {__builtin_shufflevector(u0, u0, 0, 1), __builtin_shufflevector(u0, u0, 2, 3), __builtin_shufflevector(u1, u1, 0, 1), __builtin_shufflevector(u1, u1, 2, 3)};
#pragma unroll
                  for (int q_ = 0; q_ < 4; ++q_) { const f32x2 den = (f32x2){__builtin_amdgcn_exp2f(gp[q_].x), __builtin_amdgcn_exp2f(gp[q_].y)} + (f32x2){1.f, 1.f};
                      const f32x2 res = (gp[q_] * up[q_]) * (f32x2){__builtin_amdgcn_rcpf(den.x), __builtin_amdgcn_rcpf(den.y)}; r_[2 * q_] = res.x; r_[2 * q_ + 1] = res.y; } }
                if constexpr (F8OUT) {
                    u32x2 w8; w8.x = pack_fp8x4n(r_[0], r_[1], r_[2], r_[3]); w8.y = pack_fp8x4n(r_[4], r_[5], r_[6], r_[7]);
                    if (rl < u.nvalid) *(u32x2*)((signed char*)H + (size_t)(u.orow + rl) * ldh + col0) = w8;
                } else {
                u32x4 w; w.x = cvt_pk_bf16(r_[0], r_[1]); w.y = cvt_pk_bf16(r_[2], r_[3]); w.z = cvt_pk_bf16(r_[4], r_[5]); w.w = cvt_pk_bf16(r_[6], r_[7]);
                if (rl < u.nvalid) st16(H + (size_t)(u.orow + rl) * ldh + col0, w); } }
    }
};
typedef EpiSwiGLUqT<false> EpiSwiGLUq; typedef EpiSwiGLUqT<true> EpiSwiGLUq8;
struct EpiMoeDown {
    static constexpr bool PERM = true, AFTER_DRAIN = false, PREFETCH = false, LDSPRE = false; typedef f32x4 acc_t; struct Pre {};
    bf16_t* x; const float* gate; const int* perm; const float* pw;
    __device__ __forceinline__ void operator()(const f32x4 (&acc)[2][2][4][2], const Unit& u, int wr, int wc, int fr, int fq) const {
        const int rl0 = wr * 64 + fr, col0 = u.pn * BM + wc * 32 + 8 * fq;
        int tokv[2][4]; float pv[2][4];
#pragma unroll
        for (int ai = 0; ai < 2; ++ai)
#pragma unroll
            for (int m = 0; m < 4; ++m) { const int rl = rl0 + ai * HALF + m * 16; const bool ok = rl < u.nvalid; tokv[ai][m] = ok ? perm[u.orow + rl] : 0; pv[ai][m] = ok ? pw[u.orow + rl] : 0.f; }
#pragma unroll
        for (int ai = 0; ai < 2; ++ai) {
            u32x4 xin[4][2];
#pragma unroll
            for (int m = 0; m < 4; ++m)
#pragma unroll
                for (int bj = 0; bj < 2; ++bj) xin[m][bj] = *(const u32x4*)(x + (size_t)tokv[ai][m] * 1024 + col0 + bj * HALF);
#pragma unroll
            for (int m = 0; m < 4; ++m) { const int rl = rl0 + ai * HALF + m * 16;
                if (rl < u.nvalid) { const int tok = tokv[ai][m]; const float p = pv[ai][m];
                    const float* gp = gate + (size_t)(tok >> 13) * 6144 + col0; bf16_t* xp = x + (size_t)tok * 1024 + col0;
#pragma unroll
                    for (int bj = 0; bj < 2; ++bj) { const f32x4 g0 = *(const f32x4*)(gp + bj * HALF), g1 = *(const f32x4*)(gp + bj * HALF + 4); const u32x4 xv = xin[m][bj];
                        const f32x4 v0 = (f32x4){bf_lo(xv.x), bf_hi(xv.x), bf_lo(xv.y), bf_hi(xv.y)} + (g0 * p) * acc[ai][bj][m][0], v1 = (f32x4){bf_lo(xv.z), bf_hi(xv.z), bf_lo(xv.w), bf_hi(xv.w)} + (g1 * p) * acc[ai][bj][m][1];
                        u32x4 w; w.x = cvt_pk_bf16(v0[0], v0[1]); w.y = cvt_pk_bf16(v0[2], v0[3]); w.z = cvt_pk_bf16(v1[0], v1[1]); w.w = cvt_pk_bf16(v1[2], v1[3]);
                        st16(xp + bj * HALF, w); } } } }
    }
};


struct EpiPart {
    static constexpr bool PERM = true, AFTER_DRAIN = false, PREFETCH = false, LDSPRE = false; typedef f32x4 acc_t; struct Pre {};
    float* part;
    __device__ __forceinline__ void operator()(const f32x4 (&acc)[2][2][4][2], const Unit& u, int wr, int wc, int fr, int fq) const {
        float* pt = part + (size_t)u.slice * (BM * BM) + (size_t)(wr * 64 + fr) * BM + wc * 32 + 8 * fq;
#pragma unroll
        for (int ai = 0; ai < 2; ++ai)
#pragma unroll
            for (int m = 0; m < 4; ++m) { float* pr = pt + (size_t)(ai * HALF + m * 16) * BM;
#pragma unroll
                for (int bj = 0; bj < 2; ++bj) { *(f32x4*)(pr + bj * HALF) = acc[ai][bj][m][0]; *(f32x4*)(pr + bj * HALF + 4) = acc[ai][bj][m][1]; } }
    }
};


struct EpiDelta {
    static constexpr bool PERM = true, AFTER_DRAIN = false, PREFETCH = false, LDSPRE = false; typedef f32x4 acc_t; struct Pre {};
    bf16_t* d0; bf16_t* d1; int split; const float* pw; float osc;
    __device__ __forceinline__ void operator()(const f32x4 (&acc)[2][2][4][2], const Unit& u, int wr, int wc, int fr, int fq) const {
        const int rl0 = wr * 64 + fr, col0 = u.pn * BM + wc * 32 + 8 * fq;
        float pv[2][4];
#pragma unroll
        for (int ai = 0; ai < 2; ++ai)
#pragma unroll
            for (int m = 0; m < 4; ++m) pv[ai][m] = pw[u.orow + rl0 + ai * HALF + m * 16] * osc;
#pragma unroll
        for (int ai = 0; ai < 2; ++ai)
#pragma unroll
            for (int m = 0; m < 4; ++m) { const int rl = rl0 + ai * HALF + m * 16, row = u.orow + rl; const float p = pv[ai][m];
                if (rl < u.nvalid) { bf16_t* rowp = (row < split ? d0 + (size_t)row * 1024 : d1 + (size_t)(row - split) * 1024) + col0;
#pragma unroll
                    for (int bj = 0; bj < 2; ++bj) { const f32x4 v0 = acc[ai][bj][m][0] * p, v1 = acc[ai][bj][m][1] * p;
                        u32x4 w; w.x = cvt_pk_bf16(v0[0], v0[1]); w.y = cvt_pk_bf16(v0[2], v0[3]); w.z = cvt_pk_bf16(v1[0], v1[1]); w.w = cvt_pk_bf16(v1[2], v1[3]);
                        st16(rowp + bj * HALF, w); } } }
    }
};

struct EpiDelta8 : EpiDelta { static constexpr bool FP8 = true; };
struct EpiPart8 : EpiPart { static constexpr bool FP8 = true; };
struct EpiRes8 : EpiRes { static constexpr bool FP8 = true; };

template <bool F8> struct EpiResAT {
    static constexpr bool PERM = true, AFTER_DRAIN = false, PREFETCH = false, LDSPRE = false, FP8 = F8; typedef f32x4 acc_t; struct Pre {};
    bf16_t* x; const float* gate; float osc;
    __device__ __forceinline__ void operator()(const f32x4 (&acc)[2][2][4][2], const Unit& u, int wr, int wc, int fr, int fq) const {
        const int row0 = u.orow + wr * 64 + fr, col0 = u.pn * BM + wc * 32 + 8 * fq;
        const float* gp = gate + (size_t)(u.orow >> 13) * 6144 + col0;
        f32x4 gv[2][2];
#pragma unroll
        for (int bj = 0; bj < 2; ++bj)
#pragma unroll
            for (int n = 0; n < 2; ++n) gv[bj][n] = *(const f32x4*)(gp + bj * HALF + 4 * n) * osc;
#pragma unroll
        for (int ai = 0; ai < 2; ++ai)
#pragma unroll
            for (int m = 0; m < 4; ++m) { bf16_t* rowp = x + (size_t)(row0 + ai * HALF + m * 16) * 1024 + col0;
#pragma unroll
                for (int bj = 0; bj < 2; ++bj) { const f32x4 v0 = gv[bj][0] * acc[ai][bj][m][0], v1 = gv[bj][1] * acc[ai][bj][m][1];
                    const unsigned w0 = cvt_pk_bf16(v0[0], v0[1]), w1 = cvt_pk_bf16(v0[2], v0[3]), w2 = cvt_pk_bf16(v1[0], v1[1]), w3 = cvt_pk_bf16(v1[2], v1[3]);
                    bf16_t* p = rowp + bj * HALF;
                    asm volatile("global_atomic_pk_add_bf16 %0, %1, off" :: "v"(p), "v"(w0) : "memory");
                    asm volatile("global_atomic_pk_add_bf16 %0, %1, off offset:4" :: "v"(p), "v"(w1) : "memory");
                    asm volatile("global_atomic_pk_add_bf16 %0, %1, off offset:8" :: "v"(p), "v"(w2) : "memory");
                    asm volatile("global_atomic_pk_add_bf16 %0, %1, off offset:12" :: "v"(p), "v"(w3) : "memory"); } }
    }
};

struct EpiDeltaF8 {
    static constexpr bool PERM = true, AFTER_DRAIN = false, PREFETCH = false, LDSPRE = false, FP8 = true; typedef f32x4 acc_t; struct Pre {};
    signed char* d0; const float* pw; float osc, dsc;
    __device__ __forceinline__ void operator()(const f32x4 (&acc)[2][2][4][2], const Unit& u, int wr, int wc, int fr, int fq) const {
        const int rl0 = wr * 64 + fr, col0 = u.pn * BM + wc * 32 + 8 * fq;
        float pv[2][4];
#pragma unroll
        for (int ai = 0; ai < 2; ++ai)
#pragma unroll
            for (int m = 0; m < 4; ++m) pv[ai][m] = pw[u.orow + rl0 + ai * HALF + m * 16] * (osc * dsc);
#pragma unroll
        for (int ai = 0; ai < 2; ++ai)
#pragma unroll
            for (int m = 0; m < 4; ++m) { const int rl = rl0 + ai * HALF + m * 16, row = u.orow + rl; const float p = pv[ai][m];
                if (rl < u.nvalid) { signed char* rowp = d0 + (size_t)row * 1024 + col0;
#pragma unroll
                    for (int bj = 0; bj < 2; ++bj) { const f32x4 v0 = acc[ai][bj][m][0] * p, v1 = acc[ai][bj][m][1] * p;
                        u32x2 w; w.x = pack_fp8x4n(v0[0], v0[1], v0[2], v0[3]); w.y = pack_fp8x4n(v1[0], v1[1], v1[2], v1[3]);
                        *(u32x2*)(rowp + bj * HALF) = w; } } }
    }
};
template <class Epi, class Sched, bool ALIGN_EPI = false, bool SP2 = false>
__device__ __forceinline__ void gemm_phase(PG8_LAS unsigned char* lds, const Gemm g, const Sched& S, const Epi& E, int wv_) {
    int tid_; asm volatile("v_mbcnt_lo_u32_b32 %0, -1, 0\n\tv_mbcnt_hi_u32_b32 %0, -1, %0" : "=v"(tid_)); tid_ += 64 * wv_;
    const int tid = tid_, wid = __builtin_amdgcn_readfirstlane(tid >> 6), lane = tid & 63, wr = wid >> 2, wc = wid & 3, fr = lane & 15, fq = lane >> 4;
    const int K = g.K, ntK = K / BK;
    unsigned voffA[2], voffB[2];
#pragma unroll
    for (int i = 0; i < 2; ++i) { int R, C; stage_rc(tid * 16 + i * 8192, R, C); const int Rb = Epi::PERM ? ((R & ~31) + perm32(R & 31)) : R;
        voffA[i] = (unsigned)(R * K + C) * 2u; voffB[i] = (unsigned)(Rb * K + C) * 2u; }
    const size_t kstep = (size_t)(BK * 2);
    const size_t hstep = (size_t)HALF * K * 2;
    const size_t rstep = (size_t)K * 2;
    const unsigned ldsw = (unsigned)wid * 1024u;
    const int aoff = lds_byte(wr * 64 + fr, fq * 8), boff = lds_byte(wc * 32 + fr, fq * 8);
#define PG8_SA(b, h) (((b) * 2 + (h)) * HTB)
#define PG8_SB(b, h) ((4 + (b) * 2 + (h)) * HTB)
#define PG8_STAGE(bufoff, gbase, voff) do { _Pragma("unroll") for (int _i = 0; _i < 2; ++_i) \
        __builtin_amdgcn_global_load_lds((const unsigned*)((const char*)(gbase) + (voff)[_i]), (PG8_LAS unsigned*)(lds + (bufoff) + ldsw + _i * 8192), 16, 0, 0); } while (0)
#define PG8_LDA(dst, b, h) do { _Pragma("unroll") for (int m = 0; m < 4; ++m) _Pragma("unroll") for (int k = 0; k < 2; ++k) dst[m][k] = *(const PG8_LAS bf16x8*)(lds + PG8_SA(b, h) + aoff + m * 2048 + k * 1024); } while (0)
#define PG8_LDB(dst, b, h) do { _Pragma("unroll") for (int n = 0; n < 2; ++n) _Pragma("unroll") for (int k = 0; k < 2; ++k) dst[n][k] = *(const PG8_LAS bf16x8*)(lds + PG8_SB(b, h) + boff + n * 2048 + k * 1024); } while (0)
#define PG8_MMA(ai, bj, At, Bt) do { __builtin_amdgcn_s_setprio(1); _Pragma("unroll") for (int m = 0; m < 4; ++m) _Pragma("unroll") for (int n = 0; n < 2; ++n) { \
        if constexpr (epi_fp8<Epi>::value) acc[ai][bj][m][n] = mma_f8(Bt[n][0], Bt[n][1], At[m][0], At[m][1], acc[ai][bj][m][n]); \
        else { _Pragma("unroll") for (int k = 0; k < 2; ++k) acc[ai][bj][m][n] = mma_acc(Bt[n][k], At[m][k], acc[ai][bj][m][n]); } } __builtin_amdgcn_s_setprio(0); } while (0)
#define PG8_WAIT_V(n) asm volatile("s_waitcnt vmcnt(" #n ")" ::: "memory")
#define PG8_WAIT_RX(n_) asm volatile("v_readfirstlane_b32 vcc_lo, %0\n\ts_nop 3\n\ts_cmp_eq_u32 vcc_lo, 0\n\ts_cbranch_scc1 2\n\ts_waitcnt vmcnt(" #n_ ")\n\ts_branch 1\n\ts_waitcnt vmcnt(8)" :: "v"(relax_) : "memory", "scc", "vcc")
#define PG8_WAIT_V8R() do { if constexpr (NSTR == 16) PG8_WAIT_RX(24); else if constexpr (NSTR == 8) PG8_WAIT_RX(16); else PG8_WAIT_V(8); } while (0)
#define PG8_WAIT_L(n) asm volatile("s_waitcnt lgkmcnt(" #n ")" ::: "memory")
#define PG8_BAR __builtin_amdgcn_s_barrier()
#define PG8_SCHED __builtin_amdgcn_sched_barrier(0)
    Unit cur, nxt; int ui = 0;
    if (!S.next(0, cur)) return;
    constexpr int NSTR = (SP2 && Sched::FULL) ? epi_nst<Epi>::value : 0;
    typedef typename Epi::acc_t acc_t;
    acc_t acc[2][2][4][2];
    typename Epi::Pre pre;
    { unsigned long long z0_ = 0ull; asm volatile("" : "+v"(z0_));
#pragma unroll
    for (int a = 0; a < 2; ++a)
#pragma unroll
        for (int b = 0; b < 2; ++b)
#pragma unroll
            for (int m = 0; m < 4; ++m)
#pragma unroll
                for (int n = 0; n < 2; ++n) asm volatile("v_mfma_f32_4x4x4_16b_f16 %0, %1, %1, 0" : "=&v"(acc[a][b][m][n]) : "v"(z0_)); }
    bf16x8 At[4][2], B0[2][2], B1[2][2];
    const char* cA = (const char*)g.A + (size_t)cur.arow * rstep + (size_t)cur.kt0 * (BK * 2); const char* cB = (const char*)g.Bt + (size_t)cur.brow * rstep + (size_t)cur.kt0 * (BK * 2);
    int nt = cur.nkt ? cur.nkt : ntK;
    S.a_ready(cur);
    if constexpr (SP2) {
        PG8_STAGE(PG8_SB(0, 0), cB, voffB); PG8_STAGE(PG8_SB(0, 1), cB + hstep, voffB); PG8_STAGE(PG8_SA(0, 0), cA, voffA); PG8_STAGE(PG8_SA(0, 1), cA + hstep, voffA);
        if (wr == 1) PG8_BAR;
        PG8_WAIT_V(2); PG8_BAR;
        PG8_STAGE(PG8_SB(1, 0), cB + kstep, voffB); PG8_STAGE(PG8_SA(1, 0), cA + kstep, voffA); PG8_STAGE(PG8_SB(1, 1), cB + hstep + kstep, voffB);
        PG8_WAIT_V(6); PG8_BAR;
    } else {
        PG8_STAGE(PG8_SB(0, 0), cB, voffB); PG8_STAGE(PG8_SA(0, 0), cA, voffA); PG8_STAGE(PG8_SB(0, 1), cB + hstep, voffB); PG8_STAGE(PG8_SA(0, 1), cA + hstep, voffA);
        if (wr == 1) PG8_BAR;
        PG8_WAIT_V(4); PG8_BAR;
        PG8_STAGE(PG8_SB(1, 0), cB + kstep, voffB); PG8_STAGE(PG8_SA(1, 0), cA + kstep, voffA); PG8_STAGE(PG8_SB(1, 1), cB + hstep + kstep, voffB);
        PG8_WAIT_V(6); PG8_BAR;
    }
    for (;;) {
        const bool has_next = S.next(ui + 1, nxt);
        const char* nA = has_next ? (const char*)g.A + (size_t)nxt.arow * rstep + (size_t)nxt.kt0 * (BK * 2) : cA; const char* nB = has_next ? (const char*)g.Bt + (size_t)nxt.brow * rstep + (size_t)nxt.kt0 * (BK * 2) : cB;
        for (int t = 0; t < nt; t += 2) {
            const bool last = (t == nt - 2);
            const int relax_ = (t == 0 && ui > 0) ? 1 : 0;
            const char* a1 = cA + (size_t)(t + 1) * kstep;
            const char* a2 = last ? nA : cA + (size_t)(t + 2) * kstep; const char* b2 = last ? nB : cB + (size_t)(t + 2) * kstep;
            const char* a3 = a2 + kstep; const char* b3 = b2 + kstep;
            if (last && has_next) S.a_ready(nxt);
            if constexpr (Epi::LDSPRE) { if (last) E.lds_prefetch(lds + PG8_SPARE, cur, wid, lane); }
            if constexpr (Epi::PREFETCH) { if (last) E.prefetch(pre, cur, wr, wc, fr, fq); }
            if constexpr (SP2) {
            PG8_LDB(B0, 0, 0); PG8_LDB(B1, 0, 1); PG8_SCHED; PG8_LDA(At, 0, 0); PG8_STAGE(PG8_SA(1, 1), a1 + hstep, voffA);
            PG8_WAIT_V8R(); PG8_WAIT_L(0); PG8_BAR; PG8_MMA(0, 0, At, B0); PG8_MMA(0, 1, At, B1); PG8_BAR; PG8_SCHED;
            PG8_LDA(At, 0, 1); PG8_STAGE(PG8_SB(0, 0), b2, voffB); PG8_STAGE(PG8_SB(0, 1), b2 + hstep, voffB); PG8_STAGE(PG8_SA(0, 0), a2, voffA);
            PG8_WAIT_V8R(); PG8_WAIT_L(0); PG8_BAR; PG8_MMA(1, 0, At, B0); PG8_MMA(1, 1, At, B1); PG8_BAR; PG8_SCHED;
            PG8_LDB(B0, 1, 0); PG8_LDB(B1, 1, 1); PG8_SCHED; PG8_LDA(At, 1, 0); PG8_STAGE(PG8_SA(0, 1), a2 + hstep, voffA);
            PG8_WAIT_V(8); PG8_WAIT_L(0); PG8_BAR; PG8_MMA(0, 0, At, B0); PG8_MMA(0, 1, At, B1); PG8_BAR; PG8_SCHED;
            PG8_LDA(At, 1, 1); PG8_STAGE(PG8_SB(1, 0), b3, voffB); PG8_STAGE(PG8_SB(1, 1), b3 + hstep, voffB); PG8_STAGE(PG8_SA(1, 0), a3, voffA);
            PG8_WAIT_V(8); PG8_WAIT_L(0); PG8_BAR; PG8_MMA(1, 0, At, B0); PG8_MMA(1, 1, At, B1); PG8_BAR; PG8_SCHED;
            } else {
            PG8_LDB(B0, 0, 0); PG8_SCHED; PG8_LDA(At, 0, 0); PG8_STAGE(PG8_SA(1, 1), a1 + hstep, voffA);
            PG8_WAIT_L(8); PG8_BAR; PG8_WAIT_L(0); PG8_MMA(0, 0, At, B0); PG8_BAR; PG8_SCHED;
            PG8_LDB(B1, 0, 1); PG8_STAGE(PG8_SB(0, 0), b2, voffB);
            PG8_BAR; PG8_WAIT_L(0); PG8_MMA(0, 1, At, B1); PG8_BAR;
            PG8_LDA(At, 0, 1); PG8_STAGE(PG8_SA(0, 0), a2, voffA);
            PG8_BAR; PG8_WAIT_L(0); PG8_MMA(1, 0, At, B0); PG8_BAR; PG8_SCHED;
            PG8_STAGE(PG8_SB(0, 1), b2 + hstep, voffB);
            PG8_WAIT_V(6); PG8_BAR; PG8_MMA(1, 1, At, B1); PG8_BAR;
            PG8_LDB(B0, 1, 0); PG8_SCHED; PG8_LDA(At, 1, 0); PG8_STAGE(PG8_SA(0, 1), a2 + hstep, voffA);
            PG8_WAIT_L(8); PG8_BAR; PG8_WAIT_L(0); PG8_MMA(0, 0, At, B0); PG8_BAR; PG8_SCHED;
            PG8_LDB(B1, 1, 1); PG8_STAGE(PG8_SB(1, 0), b3, voffB);
            PG8_BAR; PG8_WAIT_L(0); PG8_MMA(0, 1, At, B1); PG8_BAR;
            PG8_LDA(At, 1, 1); PG8_STAGE(PG8_SA(1, 0), a3, voffA);
            PG8_BAR; PG8_WAIT_L(0); PG8_MMA(1, 0, At, B0); PG8_BAR; PG8_SCHED;
            PG8_STAGE(PG8_SB(1, 1), b3 + hstep, voffB);
            PG8_WAIT_V(6); PG8_BAR; PG8_MMA(1, 1, At, B1); PG8_BAR;
            }
        }
        if constexpr (epi_fp8<Epi>::value) asm volatile("s_nop 15\n\ts_nop 15" ::: "memory");
        if constexpr (ALIGN_EPI) { if (wr == 0) PG8_BAR; }
        if constexpr (!Epi::AFTER_DRAIN) { if constexpr (Epi::LDSPRE) E(acc, cur, wr, wc, fr, fq, lds + PG8_SPARE); else if constexpr (Epi::PREFETCH) E(acc, cur, wr, wc, fr, fq, pre); else E(acc, cur, wr, wc, fr, fq); S.done(cur); }
        if (!has_next) break;
        { unsigned long long z2_ = 0ull; asm volatile("" : "+v"(z2_));
#pragma unroll
        for (int a = 0; a < 2; ++a)
#pragma unroll
            for (int b = 0; b < 2; ++b)
#pragma unroll
                for (int m = 0; m < 4; ++m)
#pragma unroll
                    for (int n = 0; n < 2; ++n) asm volatile("v_mfma_f32_4x4x4_16b_f16 %0, %1, %1, 0" : "=&v"(acc[a][b][m][n]) : "v"(z2_)); }
        cur = nxt; cA = nA; cB = nB; ++ui; nt = cur.nkt ? cur.nkt : ntK;
        if constexpr (ALIGN_EPI) { if (wr == 1) PG8_BAR; }
    }
    PG8_WAIT_V(0);
    if constexpr (!ALIGN_EPI) { if (wr == 0) PG8_BAR; }
    PG8_BAR;
    if constexpr (Epi::AFTER_DRAIN) { E.fused(acc, cur, wr, wc, fr, fq, lds, wid, lane); S.done(cur); }
#undef PG8_SA
#undef PG8_SB
#undef PG8_STAGE
#undef PG8_LDA
#undef PG8_LDB
#undef PG8_MMA
#undef PG8_WAIT_V
#undef PG8_WAIT_L
#undef PG8_BAR
#undef PG8_SCHED
}
}

#ifndef PG8_SP2
#define PG8_SP2 true
#endif
#ifndef PG8_ALIGN
#define PG8_ALIGN true
#endif
#ifndef MOE_I8
#define MOE_I8 1
#endif
#ifndef IN_I8
#define IN_I8 1
#endif
#ifndef GATHER_OVERLAP
#define GATHER_OVERLAP 1
#endif
#ifndef MOE_TAIL
#define MOE_TAIL 1
#endif
#ifndef MIX_ALT
#define MIX_ALT 1
#endif
#ifndef EPI_STAGGER
#define EPI_STAGGER 0
#endif
#ifndef LOCAL_SEAMS
#define LOCAL_SEAMS 1
#endif
#ifndef FP8_MOE
#define FP8_MOE 1
#endif
#ifndef FP8_DENSE
#define FP8_DENSE 1
#endif
constexpr float F8_HS = 4.f, F8_WS = 4096.f;
#ifndef RES_ALIGN
#define RES_ALIGN true
#endif
#ifndef MK_PER_PHASE
#define MK_PER_PHASE 0
#endif

constexpr int NB = 4, SEQ = 8192, T = NB * SEQ, D = 1024, NZ = 3072, DIN = 3080, FF = 2816, NE = 8, NWAVES = 8;
constexpr float EPS = 1e-6f;
#ifndef RES_ATOMIC
#define RES_ATOMIC 0
#endif
#if RES_ATOMIC
typedef pg8::EpiResAT<false> Gemm2Epi;
#else
typedef pg8::EpiRes Gemm2Epi;
#endif
#if FP8_DENSE
typedef pg8::EpiSwiGLUq8 DenseUpEpi; typedef pg8::EpiRes8 DenseDownEpi;
#else
typedef pg8::EpiSwiGLUq DenseUpEpi; typedef pg8::EpiRes DenseDownEpi;
#endif
#ifndef D_FP8
#define D_FP8 1
#endif
constexpr float F8_DS = 64.f;
#if FP8_MOE
typedef pg8::EpiDelta8 MoeDownEpi; typedef pg8::EpiPart8 MoePartEpi; typedef pg8::EpiSwiGLUq8 MoeUpEpi; constexpr int MOE_DOWN_KT = FF / 128;
#else
typedef pg8::EpiDelta MoeDownEpi; typedef pg8::EpiPart MoePartEpi; typedef pg8::EpiSwiGLUq MoeUpEpi; constexpr int MOE_DOWN_KT = FF / 64;
#endif
constexpr size_t MiB = 1u << 20, KiB = 1u << 10;
constexpr size_t WS_CTL = 0, CTL_ZERO_BYTES = 32 * KiB;
constexpr size_t WS_MOD = 1 * MiB, WS_WG8 = 1 * MiB + 256 * KiB, WS_WR8 = 1 * MiB + 384 * KiB;
constexpr size_t WS_G = 2 * MiB, WS_RL = 3 * MiB, WS_TOPI = 4 * MiB, WS_TOPP = 4 * MiB + 256 * KiB, WS_PERM = 4 * MiB + 512 * KiB, WS_PW = 4 * MiB + 768 * KiB;
constexpr size_t WS_CNT = 5 * MiB, WS_TILES = 5 * MiB + 64 * KiB, WS_NT = 5 * MiB + 128 * KiB, WS_CAR = 6 * MiB, WS_HIN = 7 * MiB;
constexpr size_t WS_WIN = 8 * MiB, WS_WOUT = 20 * MiB, WS_WF1 = 24 * MiB, WS_WF2 = 35 * MiB, WS_WE1 = 41 * MiB, WS_WE2 = 129 * MiB;
constexpr size_t WS_HB = 174 * MiB, WS_Z = 238 * MiB, WS_HRAW = 430 * MiB, WS_END = 512 * MiB;
constexpr int D0_SPLIT = 16896;
constexpr size_t WS_D0A = 8 * MiB, WS_D0B = WS_HRAW, WS_D1 = 41 * MiB, WS_PART = WS_HRAW + (size_t)(T + 256) * D;
constexpr int PART_SLOTS = (int)((WS_END - WS_PART) / (256 * 256 * 4));
static_assert((size_t)D0_SPLIT * D * 2 <= 33 * MiB && (size_t)(T - D0_SPLIT) * D * 2 <= (size_t)(T + 256) * D && WS_D1 + (size_t)T * D * 2 <= 129 * MiB, "deferred-residual map");
constexpr int MAXTILES = 160;
static_assert(WS_WE2 + (size_t)NE * D * FF * 2 <= WS_HB && WS_Z + (size_t)(T + 256) * FF * 2 <= WS_HRAW && WS_HRAW + (size_t)(T + 256) * D * 2 <= WS_END, "d_ws map");
constexpr int CW_TMO = 0, CW_BAR = 4096;
constexpr int RING_OFF = 0, RING_BYTES = 131072;
constexpr int LDSCTL_OFF = RING_BYTES, MISC_OFF = LDSCTL_OFF + 320;
constexpr int LDS_BYTES = 147456;

#define GAS __attribute__((address_space(1)))
#define LAS __attribute__((address_space(3)))
typedef unsigned short bf16;
typedef unsigned v4u __attribute__((ext_vector_type(4)));
typedef unsigned v2u __attribute__((ext_vector_type(2)));
typedef float f32x4 __attribute__((ext_vector_type(4)));
typedef float f32x2 __attribute__((ext_vector_type(2)));
typedef GAS unsigned gu32;
#define RLX_AGENT __ATOMIC_RELAXED, __HIP_MEMORY_SCOPE_AGENT
#define LDS_WAIT() asm volatile("s_waitcnt lgkmcnt(0)" ::: "memory")
#define VM_WAIT() asm volatile("s_waitcnt vmcnt(0)" ::: "memory")
__device__ __forceinline__ unsigned f2bf(float f) { unsigned u = __builtin_bit_cast(unsigned, f); return (u + 0x7fffu + ((u >> 16) & 1u)) >> 16; }
__device__ __forceinline__ f32x4 fp8x4_f(unsigned w) { return (f32x4){__builtin_amdgcn_cvt_f32_fp8((int)w, 0), __builtin_amdgcn_cvt_f32_fp8((int)w, 1), __builtin_amdgcn_cvt_f32_fp8((int)w, 2), __builtin_amdgcn_cvt_f32_fp8((int)w, 3)}; }
__device__ __forceinline__ f32x4 zero4() { f32x4 z; asm volatile("v_mov_b32 %0, 0" : "=v"(z.x)); asm volatile("v_mov_b32 %0, 0" : "=v"(z.y)); asm volatile("v_mov_b32 %0, 0" : "=v"(z.z)); asm volatile("v_mov_b32 %0, 0" : "=v"(z.w)); return z; }
__device__ __forceinline__ unsigned pk2(float lo, float hi) { unsigned r; asm("v_cvt_pk_bf16_f32 %0, %1, %2" : "=v"(r) : "v"(lo), "v"(hi)); return r; }
__device__ __forceinline__ float bf2f(unsigned v) { return __builtin_bit_cast(float, v << 16); }
__device__ __forceinline__ float bflo(unsigned w) { return __builtin_bit_cast(float, w << 16); }
__device__ __forceinline__ float bfhi(unsigned w) { return __builtin_bit_cast(float, w & 0xffff0000u); }
__device__ __forceinline__ float sigmoid_f(float v) { return __builtin_amdgcn_rcpf(1.f + __builtin_amdgcn_exp2f(-1.4426950408889634f * v)); }
__device__ __forceinline__ float silu_acc(float v) { return v * __builtin_amdgcn_rcpf(1.f + __builtin_amdgcn_exp2f(-1.4426950408889634f * v)); }
__device__ __forceinline__ float logsigmoid_f(float v) { return fminf(v, 0.f) - log1pf(__expf(-fabsf(v))); }
__device__ __forceinline__ float softplus_f(float v) { return fmaxf(v, 0.f) + log1pf(__expf(-fabsf(v))); }
__device__ __forceinline__ float gelu_tanh_f(float v) { return v * __builtin_amdgcn_rcpf(1.f + __builtin_amdgcn_exp2f(v * fmaf(v * v, -0.10294324f, -2.3022082f))); }

#define XB_TMO      128
#define XB_XCNT(j)  (256  + 64 * (j))
#define XB_XSUB(j)  (1280 + 64 * (j))
#define XB_XGEN(j)  (2304 + 64 * (j))
#define XB_TOP      3328
#define XB_TOPGEN   3392
#define XCD_BAR_WORDS 3456
#define XB_SPIN_CAP (1u << 18)

__device__ __forceinline__ unsigned xb_ld(unsigned* p)              { return __hip_atomic_load(p, __ATOMIC_RELAXED, __HIP_MEMORY_SCOPE_AGENT); }
__device__ __forceinline__ unsigned xb_add(unsigned* p, unsigned v) { return __hip_atomic_fetch_add(p, v, __ATOMIC_RELAXED, __HIP_MEMORY_SCOPE_AGENT); }
__device__ __forceinline__ unsigned xb_xcc_id() { return (unsigned)__builtin_amdgcn_s_getreg((3 << 11) | 20) & 0xFu; }
#define XB_SPIN(cond, bar) do { unsigned _sp = 0; while (cond) { __builtin_amdgcn_s_sleep(1); \
    if ((++_sp & 255u) == 0u) { if (xb_ld(&(bar)[XB_TMO])) break; if (_sp > XB_SPIN_CAP) { atomicAdd(&(bar)[XB_TMO], 1u); break; } } } } while (0)

struct XcdBarrier {
    unsigned* bar; unsigned x;
    unsigned lead;
    volatile LAS unsigned* st;
};

__device__ __forceinline__ XcdBarrier xcd_barrier_post(unsigned* bar, volatile LAS unsigned* st) {
    XcdBarrier b; b.bar = bar; b.x = xb_xcc_id(); b.st = st; b.lead = __builtin_amdgcn_readfirstlane(threadIdx.x >> 6) == 0 ? 1u : 0u;
    if (threadIdx.x == 0) (void)xb_add(&bar[XB_XCNT(b.x)], 1u);
    return b;
}
__device__ __forceinline__ void xcd_barrier_complete(unsigned* bar, unsigned x, unsigned& nloc, unsigned& nx) {
    const unsigned G = gridDim.x * gridDim.y * gridDim.z;
    unsigned sum, cnt, mine, sp = 0u;
    for (;;) {
        sum = 0u; cnt = 0u; mine = 0u;
#pragma unroll
        for (unsigned j = 0; j < 16; ++j) { const unsigned c = xb_ld(&bar[XB_XCNT(j)]); sum += c; cnt += (c > 0u) ? 1u : 0u; mine = (j == x) ? c : mine; }
        if (sum == G) break;
        __builtin_amdgcn_s_sleep(1);
        if ((++sp & 255u) == 0u) { if (xb_ld(&bar[XB_TMO])) break; if (sp > XB_SPIN_CAP) { atomicAdd(&bar[XB_TMO], 1u); break; } }
    }
    nloc = mine > 0u ? mine : 1u; nx = cnt > 0u ? cnt : 1u;
}

__device__ __forceinline__ void xcd_barrier(const XcdBarrier& b) {
    asm volatile("s_waitcnt vmcnt(0)" ::: "memory");
    __syncthreads();
    int l0_; asm volatile("v_mbcnt_lo_u32_b32 %0, -1, 0\n\tv_mbcnt_hi_u32_b32 %0, -1, %0" : "=v"(l0_));
    if (b.lead && l0_ == 0) {
        unsigned* bar = b.bar;
        __builtin_amdgcn_s_waitcnt(0);
        unsigned nloc = b.st[0], nx = b.st[1];
        if (nloc == 0u) { xcd_barrier_complete(bar, b.x, nloc, nx); b.st[0] = nloc; b.st[1] = nx; }
        const unsigned old = xb_add(&bar[XB_XSUB(b.x)], 1u);
        const unsigned gen = old / nloc;
        if (old + 1u == (gen + 1u) * nloc) {
            __builtin_amdgcn_fence(__ATOMIC_RELEASE, "agent");
            asm volatile("s_waitcnt vmcnt(0)" ::: "memory");
            const unsigned og = xb_add(&bar[XB_TOP], 1u);
            const unsigned tg = og / nx;
            if (og + 1u == (tg + 1u) * nx) xb_add(&bar[XB_TOPGEN], 1u);
            else XB_SPIN(xb_ld(&bar[XB_TOPGEN]) == tg, bar);
            __builtin_amdgcn_fence(__ATOMIC_ACQUIRE, "agent");
            xb_add(&bar[XB_XGEN(b.x)], 1u);
            asm volatile("s_waitcnt vmcnt(0)" ::: "memory");
        } else {
            XB_SPIN(xb_ld(&bar[XB_XGEN(b.x)]) == gen, bar);
            __builtin_amdgcn_fence(__ATOMIC_ACQUIRE, "agent");
            asm volatile("s_waitcnt vmcnt(0)" ::: "memory");
        }
    }
    __syncthreads();
}
#define GB_CNT(g)  (XCD_BAR_WORDS + 64 * (1 + (g)))
__device__ __forceinline__ void grp_barrier_post(unsigned* bar, unsigned g, unsigned x) { __hip_atomic_fetch_or(&bar[GB_CNT(g) + 1], 1u << x, __ATOMIC_RELAXED, __HIP_MEMORY_SCOPE_AGENT); }
__device__ __forceinline__ void grp_barrier(const XcdBarrier& b, unsigned g, unsigned tgt, volatile LAS unsigned* st2) {
    asm volatile("s_waitcnt vmcnt(0)" ::: "memory");
    __syncthreads();
    int l0_; asm volatile("v_mbcnt_lo_u32_b32 %0, -1, 0\n\tv_mbcnt_hi_u32_b32 %0, -1, %0" : "=v"(l0_));
    if (b.lead && l0_ == 0) {
        unsigned* bar = b.bar;
        __builtin_amdgcn_s_waitcnt(0);
        unsigned mode = st2[0];
        if (mode == 0u) { const unsigned m = xb_ld(&bar[GB_CNT(g) + 1]); mode = (m != 0u && (m & (m - 1u)) == 0u) ? 1u : 2u; st2[0] = mode; }
        if (mode != 1u) { __builtin_amdgcn_fence(__ATOMIC_RELEASE, "agent"); asm volatile("s_waitcnt vmcnt(0)" ::: "memory"); }
        (void)xb_add(&bar[GB_CNT(g)], 1u);
        XB_SPIN(xb_ld(&bar[GB_CNT(g)]) < tgt, bar);
        __builtin_amdgcn_fence(__ATOMIC_ACQUIRE, "agent");
        asm volatile("s_waitcnt vmcnt(0)" ::: "memory");
    }
    __syncthreads();
}

struct Frame {
    LAS unsigned char* lds;
    volatile LAS unsigned* MISC;
    gu32* ctl;
    int tid, lane, wave;
    int vcu, G;
    const float *x, *c, *w_ada, *b_ada, *g_norm_mix, *g_norm_ffn, *w_in, *w_conv_qk, *b_conv_qk, *b_gates, *w_conv_lru, *b_conv_lru, *w_lru_a, *b_lru_a, *w_lru_x, *b_lru_x, *lru_lambda, *g_mix_out, *w_out;
    const float *w_ff_gate, *w_ff_up, *w_ff_down, *w_router, *b_router, *w_exp_gate, *w_exp_up, *w_exp_down, *g_final;
    float* out;
    float *MOD, *WG8, *WR8, *G8, *RL, *TOPP, *PW, *CAR, *HIN, *HRAW, *CLOC, *MST, *SA, *SAS, *SBF1, *SBE1, *SBIN, *SBINX, *SBFX;
    int *TOPI, *PERM, *CNT, *TILES, *NT, *POS1, *POS0; bf16 *D0A, *D0B, *D1, *HB8F, *HB8R; float* PART;
    bf16 *WIN, *WOUT, *WF1, *WF2, *WE1, *WE2, *HB, *Z, *HID, *ASORT, *XB;
};

template <int CTRL, int RM, int BM> __device__ __forceinline__ float dpp_f(float old, float v) {
    return __builtin_bit_cast(float, __builtin_amdgcn_update_dpp(__builtin_bit_cast(int, old), __builtin_bit_cast(int, v), CTRL, RM, BM, false)); }
__device__ __forceinline__ float wave_sum(float v) {
#pragma unroll
    for (int o = 1; o < 64; o <<= 1) v += __shfl_xor(v, o);
    return v;
}
__device__ __forceinline__ float wave_sum_dpp(float v) {
    v += dpp_f<0xB1, 0xf, 0xf>(0.f, v); v += dpp_f<0x4E, 0xf, 0xf>(0.f, v); v += dpp_f<0x124, 0xf, 0xf>(0.f, v); v += dpp_f<0x128, 0xf, 0xf>(0.f, v);
    v += dpp_f<0x142, 0xa, 0xf>(0.f, v);
    v += dpp_f<0x143, 0xc, 0xf>(0.f, v);
    return __builtin_bit_cast(float, __builtin_amdgcn_readlane(__builtin_bit_cast(int, v), 63));
}
__device__ __forceinline__ float wave_max(float v) {
    v = fmaxf(v, dpp_f<0xB1, 0xf, 0xf>(v, v)); v = fmaxf(v, dpp_f<0x4E, 0xf, 0xf>(v, v)); v = fmaxf(v, dpp_f<0x124, 0xf, 0xf>(v, v)); v = fmaxf(v, dpp_f<0x128, 0xf, 0xf>(v, v));
    v = fmaxf(v, dpp_f<0x142, 0xa, 0xf>(v, v)); v = fmaxf(v, dpp_f<0x143, 0xc, 0xf>(v, v));
    return __builtin_bit_cast(float, __builtin_amdgcn_readlane(__builtin_bit_cast(int, v), 63));
}

#define R4_STEP(OP, CTRL) asm volatile(OP " %0, %0, %0 " CTRL "\n\t" OP " %1, %1, %1 " CTRL "\n\t" OP " %2, %2, %2 " CTRL "\n\t" OP " %3, %3, %3 " CTRL : "+v"(a), "+v"(b), "+v"(c), "+v"(d))
__device__ __forceinline__ void wave_sum4(float& a, float& b, float& c, float& d) {
    asm volatile("s_nop 1" : "+v"(a), "+v"(b), "+v"(c), "+v"(d));
    R4_STEP("v_add_f32_dpp", "quad_perm:[1,0,3,2] row_mask:0xf bank_mask:0xf"); R4_STEP("v_add_f32_dpp", "quad_perm:[2,3,0,1] row_mask:0xf bank_mask:0xf");
    R4_STEP("v_add_f32_dpp", "row_ror:4 row_mask:0xf bank_mask:0xf"); R4_STEP("v_add_f32_dpp", "row_ror:8 row_mask:0xf bank_mask:0xf");
    R4_STEP("v_add_f32_dpp", "row_bcast:15 row_mask:0xa bank_mask:0xf"); R4_STEP("v_add_f32_dpp", "row_bcast:31 row_mask:0xc bank_mask:0xf");
    a = __builtin_bit_cast(float, __builtin_amdgcn_readlane(__builtin_bit_cast(int, a), 63)); b = __builtin_bit_cast(float, __builtin_amdgcn_readlane(__builtin_bit_cast(int, b), 63));
    c = __builtin_bit_cast(float, __builtin_amdgcn_readlane(__builtin_bit_cast(int, c), 63)); d = __builtin_bit_cast(float, __builtin_amdgcn_readlane(__builtin_bit_cast(int, d), 63));
}
__device__ __forceinline__ void wave_max4(float& a, float& b, float& c, float& d) {
    asm volatile("s_nop 1" : "+v"(a), "+v"(b), "+v"(c), "+v"(d));
    R4_STEP("v_max_f32_dpp", "quad_perm:[1,0,3,2] row_mask:0xf bank_mask:0xf"); R4_STEP("v_max_f32_dpp", "quad_perm:[2,3,0,1] row_mask:0xf bank_mask:0xf");
    R4_STEP("v_max_f32_dpp", "row_ror:4 row_mask:0xf bank_mask:0xf"); R4_STEP("v_max_f32_dpp", "row_ror:8 row_mask:0xf bank_mask:0xf");
    R4_STEP("v_max_f32_dpp", "row_bcast:15 row_mask:0xa bank_mask:0xf"); R4_STEP("v_max_f32_dpp", "row_bcast:31 row_mask:0xc bank_mask:0xf");
    a = __builtin_bit_cast(float, __builtin_amdgcn_readlane(__builtin_bit_cast(int, a), 63)); b = __builtin_bit_cast(float, __builtin_amdgcn_readlane(__builtin_bit_cast(int, b), 63));
    c = __builtin_bit_cast(float, __builtin_amdgcn_readlane(__builtin_bit_cast(int, c), 63)); d = __builtin_bit_cast(float, __builtin_amdgcn_readlane(__builtin_bit_cast(int, d), 63));
}
template <int X> __device__ __forceinline__ float lane_xor(float v) {
    if constexpr (X == 1) return dpp_f<0xB1, 0xf, 0xf>(v, v);
    else if constexpr (X == 2) return dpp_f<0x4E, 0xf, 0xf>(v, v);
    else if constexpr (X == 4) { const float r = dpp_f<0x104, 0xf, 0x5>(v, v); return dpp_f<0x114, 0xf, 0xa>(r, v); }
    else if constexpr (X == 8) { const float r = dpp_f<0x108, 0xf, 0x3>(v, v); return dpp_f<0x118, 0xf, 0xc>(r, v); }
    else return __shfl_xor(v, X);
}

struct TrD { const float* W; bf16* WT; int ldw, K, k0, n0, q8; };
constexpr int NTRITEMS = 2 * 512 + 1408 + NE * 1408;
__device__ __forceinline__ TrD tr_desc(Frame& F, int it) {
    TrD d; int r;
    d.q8 = ((FP8_MOE && it >= 2432) || (FP8_DENSE && it >= 1024 && it < 2432)) ? 1 : 0;
    if (it < 1024) { const int l = it >> 9; r = it & 511; d.W = F.w_out + (size_t)l * D * D; d.WT = F.WOUT + (size_t)l * D * D; d.K = D; }
    else if (it < 2432) { r = it - 1024; d.W = F.w_ff_down; d.WT = F.WF2; d.K = FF; }
    else { const int e = (it - 2432) / 1408; r = (it - 2432) % 1408; d.W = F.w_exp_down + (size_t)e * FF * D; d.WT = FP8_MOE ? (bf16*)((signed char*)F.WE2 + (size_t)e * D * FF) : F.WE2 + (size_t)e * D * FF; d.K = FF; }
    d.ldw = D; d.k0 = 64 * (r >> 5); d.n0 = 32 * (r & 31); return d;
}
__device__ __forceinline__ void tr_load(float (&wv)[32], const TrD& d, int lane) {
#pragma unroll
    for (int i = 0; i < 32; ++i) wv[i] = d.W[(size_t)(d.k0 + 2 * i + (lane >> 5)) * d.ldw + d.n0 + (lane & 31)];
}
__device__ __forceinline__ void tr_store(const float (&wv)[32], const TrD& d, LAS float* scr, int lane) {
#pragma unroll
    for (int i = 0; i < 32; ++i) scr[(2 * i + (lane >> 5)) * 33 + (lane & 31)] = wv[i];
    LDS_WAIT(); asm volatile("" ::: "memory");
    const int c = lane & 7;
#pragma unroll
    for (int j = 0; j < 4; ++j) { const int n = (lane >> 3) + 8 * j; const LAS float* s = scr + (8 * c) * 33 + n;
        if (d.q8) { v2u o8; o8.x = pg8::pack_fp8x4(s[0 * 33], s[1 * 33], s[2 * 33], s[3 * 33], F8_WS); o8.y = pg8::pack_fp8x4(s[4 * 33], s[5 * 33], s[6 * 33], s[7 * 33], F8_WS);
            *(GAS v2u*)((signed char*)d.WT + (size_t)(d.n0 + n) * d.K + d.k0 + 8 * c) = o8; }
        else {
        v4u o; o.x = pk2(s[0 * 33], s[1 * 33]); o.y = pk2(s[2 * 33], s[3 * 33]); o.z = pk2(s[4 * 33], s[5 * 33]); o.w = pk2(s[6 * 33], s[7 * 33]);
        *(GAS v4u*)(d.WT + (size_t)(d.n0 + n) * d.K + d.k0 + 8 * c) = o; } }
    LDS_WAIT(); asm volatile("" ::: "memory");
}

__device__ __forceinline__ void p0_prologue(Frame& F) {
    {
        LAS float* red = (LAS float*)(F.lds + RING_OFF);
        for (int u = blockIdx.x; u < 192; u += F.G) {
            const int l = u / 96, cb = u % 96, cg = F.lane & 15, ks = F.lane >> 4;
            const float* W = F.w_ada + (size_t)l * D * 6144 + cb * 64 + 4 * cg;
            const int kb = F.wave * 128;
            f32x4 a0 = zero4(), a1 = a0, a2 = a0, a3 = a0;
            for (int h2 = 0; h2 < 2; ++h2) {
                f32x4 wv[16];
#pragma unroll
                for (int i = 0; i < 16; ++i) wv[i] = *(const f32x4*)(W + (size_t)(kb + 64 * h2 + 4 * i + ks) * 6144);
#pragma unroll
                for (int i = 0; i < 16; ++i) { const int kk = kb + 64 * h2 + 4 * i + ks;
                    a0 += wv[i] * silu_acc(F.c[kk]); a1 += wv[i] * silu_acc(F.c[D + kk]); a2 += wv[i] * silu_acc(F.c[2 * D + kk]); a3 += wv[i] * silu_acc(F.c[3 * D + kk]); }
            }
#pragma unroll
            for (int o = 16; o < 64; o <<= 1) {
#pragma unroll
                for (int e = 0; e < 4; ++e) { a0[e] += __shfl_xor(a0[e], o); a1[e] += __shfl_xor(a1[e], o); a2[e] += __shfl_xor(a2[e], o); a3[e] += __shfl_xor(a3[e], o); } }
            if (ks == 0) { *(LAS f32x4*)(red + (F.wave * 4 + 0) * 64 + 4 * cg) = a0; *(LAS f32x4*)(red + (F.wave * 4 + 1) * 64 + 4 * cg) = a1; *(LAS f32x4*)(red + (F.wave * 4 + 2) * 64 + 4 * cg) = a2; *(LAS f32x4*)(red + (F.wave * 4 + 3) * 64 + 4 * cg) = a3; }
            __syncthreads();
            if (F.tid < 256) { const int b = F.tid >> 6, cl = F.tid & 63; float s = F.b_ada[l * 6144 + cb * 64 + cl];
#pragma unroll
                for (int w = 0; w < 8; ++w) s += red[(w * 4 + b) * 64 + cl];
                F.MOD[(l * 4 + b) * 6144 + cb * 64 + cl] = s; }
            __syncthreads();
        }
    }
    {
        const int gt = blockIdx.x * (NWAVES * 64) + F.tid, NT_ = F.G * NWAVES * 64;
        for (int i = gt; i < 2 * 8 * D; i += NT_) { const int l = i >> 13, j = (i >> 10) & 7, k = i & 1023; F.WG8[i] = F.w_in[(size_t)l * D * DIN + (size_t)k * DIN + 2048 + j]; }
        for (int i = gt; i < 8 * D; i += NT_) { const int j = i >> 10, k = i & 1023; F.WR8[i] = F.w_router[k * 8 + j]; }
    }
    static_assert(IN_I8 && MOE_I8, "the bf16 copies of w_in and of the gate/up projections are not built any more");
    __syncthreads();
    LAS float* scr = (LAS float*)(F.lds + RING_OFF + F.wave * 16384);
    const int gw = F.vcu * NWAVES + F.wave, NGW = F.G * NWAVES;
    float wa[32], wb[32];
    int it = gw;
    if (it < NTRITEMS) tr_load(wa, tr_desc(F, it), F.lane);
    while (it < NTRITEMS) {
        if (it + NGW < NTRITEMS) tr_load(wb, tr_desc(F, it + NGW), F.lane);
        tr_store(wa, tr_desc(F, it), scr, F.lane);
        it += NGW; if (it >= NTRITEMS) break;
        if (it + NGW < NTRITEMS) tr_load(wa, tr_desc(F, it + NGW), F.lane);
        tr_store(wb, tr_desc(F, it), scr, F.lane);
        it += NGW;
    }
    __syncthreads();
}
struct StripD { const float* W; int ldw, ns0, nd0; signed char* WQ; float* SB; float sfac; };
constexpr int NSTRIP_FF = (MOE_I8 ? 9 : 1) * 176, NSTRIP = NSTRIP_FF + (IN_I8 ? 2 * 96 : 0);
__device__ __forceinline__ StripD strip_desc(Frame& F, int s) {
    StripD d;
    if (s < NSTRIP_FF) { const int m = s / 176, r = s % 176, up = r / 88, nb = r % 88; d.ns0 = 32 * nb; d.sfac = up ? -0.6931471805599453f : -1.4426950408889634f; d.nd0 = (d.ns0 >> 7) * 256 + 128 * up + (d.ns0 & 127); d.ldw = FF;
        d.W = m == 0 ? (up ? F.w_ff_up : F.w_ff_gate) : (up ? F.w_exp_up : F.w_exp_gate) + (size_t)(m - 1) * D * FF;
        d.WQ = m == 0 ? (signed char*)F.WF1 : (signed char*)F.WE1 + (size_t)(m - 1) * 2 * FF * D; d.SB = m == 0 ? F.SBF1 : F.SBE1 + (m - 1) * 2 * FF; }
    else { const int t = s - NSTRIP_FF, l = t / 96, nb = t % 96; d.sfac = 1.f; d.ns0 = nb < 64 ? 32 * nb : 2056 + 32 * (nb - 64); d.nd0 = nb < 64 ? 32 * nb : 2048 + 32 * (nb - 64); d.ldw = DIN;
        d.W = F.w_in + (size_t)l * D * DIN; d.WQ = (signed char*)F.WIN + (size_t)l * NZ * D; d.SB = F.SBIN + l * NZ; }
    return d;
}
__device__ __forceinline__ void strip_load(float (&v)[64], const StripD& d, int wave, int lane) {
    const int n = lane & 31, k0 = 128 * wave + 64 * (lane >> 5);
#pragma unroll
    for (int i = 0; i < 64; ++i) v[i] = d.W[(size_t)(k0 + i) * d.ldw + d.ns0 + n];
}
__device__ __forceinline__ void strip_quant(const float (&v)[64], const StripD& d, LAS float* smax, int wave, int lane) {
    const int n = lane & 31, kh = lane >> 5, k0 = 128 * wave + 64 * kh;
    float m = 0.f;
#pragma unroll
    for (int i = 0; i < 64; ++i) m = fmaxf(m, fabsf(v[i]));
    m = fmaxf(m, __shfl_xor(m, 32));
    if (lane < 32) smax[wave * 32 + n] = m;
    __syncthreads();
    float mm = 0.f;
#pragma unroll
    for (int w = 0; w < 8; ++w) mm = fmaxf(mm, smax[w * 32 + n]);
    const float inv = mm > 0.f ? 127.f / mm : 0.f;
    signed char* dst = d.WQ + (size_t)(d.nd0 + n) * 1024 + k0;
#pragma unroll
    for (int c = 0; c < 4; ++c) { v4u o; unsigned* op = (unsigned*)&o;
#pragma unroll
        for (int q = 0; q < 4; ++q) { const int i = 16 * c + 4 * q;
            const int q0 = __float2int_rn(v[i] * inv), q1 = __float2int_rn(v[i + 1] * inv), q2 = __float2int_rn(v[i + 2] * inv), q3 = __float2int_rn(v[i + 3] * inv);
            op[q] = (unsigned)(q0 & 255) | ((unsigned)(q1 & 255) << 8) | ((unsigned)(q2 & 255) << 16) | ((unsigned)q3 << 24); }
        *(GAS v4u*)(dst + 16 * c) = o; }
    if (wave == 0 && kh == 0) d.SB[d.nd0 + n] = mm * (1.f / 127.f) * d.sfac;
}
__device__ __forceinline__ void quant_weights(Frame& F) {
    LAS float* smax = (LAS float*)(F.lds + RING_OFF);
    __syncthreads();
    float va[64], vb[64];
    int s = blockIdx.x;
    if (s < NSTRIP) strip_load(va, strip_desc(F, s), F.wave, F.lane);
    while (s < NSTRIP) {
        if (s + F.G < NSTRIP) strip_load(vb, strip_desc(F, s + F.G), F.wave, F.lane);
        strip_quant(va, strip_desc(F, s), smax, F.wave, F.lane);
        s += F.G; if (s >= NSTRIP) break;
        if (s + F.G < NSTRIP) strip_load(va, strip_desc(F, s + F.G), F.wave, F.lane);
        strip_quant(vb, strip_desc(F, s), smax + 256, F.wave, F.lane);
        s += F.G;
    }
    __syncthreads();
}

#define BFLY_STEP(N_, X_) do { _Pragma("unroll") for (int i_ = 0; i_ < (N_) / 2; ++i_) { const bool up_ = (lane & (X_)) != 0; const float send_ = up_ ? p[2 * i_] : p[2 * i_ + 1], keep_ = up_ ? p[2 * i_ + 1] : p[2 * i_]; p[i_] = keep_ + lane_xor<(X_)>(send_); } } while (0)
template <bool XF32>
__device__ __forceinline__ void norm_load(f32x4 (&v)[4][4], const void* xin, size_t row, int lane) {
#pragma unroll
    for (int r = 0; r < 4; ++r)
#pragma unroll
        for (int j = 0; j < 2; ++j) {
            if (XF32) { const GAS f32x4* p = (const GAS f32x4*)((const float*)xin + (row + r) * D + 8 * lane + 512 * j); v[r][2 * j] = p[0]; v[r][2 * j + 1] = p[1]; }
            else { const v4u x = *(const GAS v4u*)((const bf16*)xin + (row + r) * D + 8 * lane + 512 * j);
                v[r][2 * j] = (f32x4){bflo(x.x), bfhi(x.x), bflo(x.y), bfhi(x.y)}; v[r][2 * j + 1] = (f32x4){bflo(x.z), bfhi(x.z), bflo(x.w), bfhi(x.w)}; } }
}
template <bool SMALL, bool QOUT>
__device__ __forceinline__ void norm_batch(f32x4 (&v)[4][4], const f32x4 (&gs)[4], const f32x4 (&shv)[4], bf16* Hrow0, const LAS float* wl, const float* bsm, float* Srow0, int lane, float* SArow0) {
    float s[4];
#pragma unroll
    for (int r = 0; r < 4; ++r) { s[r] = 0.f;
#pragma unroll
        for (int j = 0; j < 4; ++j) s[r] += (v[r][j].x * v[r][j].x + v[r][j].y * v[r][j].y) + (v[r][j].z * v[r][j].z + v[r][j].w * v[r][j].w); }
    wave_sum4(s[0], s[1], s[2], s[3]);
#pragma unroll
    for (int r = 0; r < 4; ++r) { const float rstd = __builtin_amdgcn_rsqf(s[r] * (1.f / D) + EPS);
#pragma unroll
        for (int j = 0; j < 4; ++j) v[r][j] = v[r][j] * rstd * gs[j] + shv[j];
        if (!QOUT) {
#pragma unroll
        for (int j = 0; j < 2; ++j) { v4u o; o.x = pk2(v[r][2 * j].x, v[r][2 * j].y); o.y = pk2(v[r][2 * j].z, v[r][2 * j].w); o.z = pk2(v[r][2 * j + 1].x, v[r][2 * j + 1].y); o.w = pk2(v[r][2 * j + 1].z, v[r][2 * j + 1].w);
            *(GAS v4u*)(Hrow0 + (size_t)r * D + 8 * lane + 512 * j) = o; } } }
    if (QOUT) {
        float mx[4];
#pragma unroll
        for (int r = 0; r < 4; ++r) { mx[r] = 0.f;
#pragma unroll
            for (int j = 0; j < 4; ++j) mx[r] = fmaxf(fmaxf(mx[r], fmaxf(fabsf(v[r][j].x), fabsf(v[r][j].y))), fmaxf(fabsf(v[r][j].z), fabsf(v[r][j].w))); }
        wave_max4(mx[0], mx[1], mx[2], mx[3]);
#pragma unroll
        for (int r = 0; r < 4; ++r) { const float inv = mx[r] > 0.f ? 127.f / mx[r] : 0.f;
            signed char* hq = (signed char*)Hrow0 + (size_t)r * D;
#pragma unroll
            for (int j = 0; j < 2; ++j) { v2u o;
#pragma unroll
                for (int hh = 0; hh < 2; ++hh) { const f32x4 a = v[r][2 * j + hh] * inv + 12582912.f; const float a0 = a.x, a1 = a.y, a2 = a.z, a3 = a.w;
                    const unsigned w_ = __builtin_amdgcn_perm(__builtin_amdgcn_perm(__builtin_bit_cast(unsigned, a3), __builtin_bit_cast(unsigned, a2), 0x0c0c0400u), __builtin_amdgcn_perm(__builtin_bit_cast(unsigned, a1), __builtin_bit_cast(unsigned, a0), 0x0c0c0400u), 0x05040100u);
                    if (hh) o.y = w_; else o.x = w_; }
                *(GAS v2u*)(hq + 8 * lane + 512 * j) = o; }
            if (lane == 0) SArow0[r] = mx[r] * (1.f / 127.f); }
    }
    if (SMALL) {
        float p[32];
#pragma unroll
        for (int q = 0; q < 8; ++q) {
            f32x2 e0 = {0.f, 0.f}, e1 = {0.f, 0.f}, e2 = {0.f, 0.f}, e3 = {0.f, 0.f};
#pragma unroll
            for (int j = 0; j < 4; ++j) { const f32x4 w = ((const LAS f32x4*)wl)[(q * 4 + j) * 64 + lane];
                const f32x2 wl2 = __builtin_shufflevector(w, w, 0, 1), wh2 = __builtin_shufflevector(w, w, 2, 3);
                e0 = __builtin_shufflevector(v[0][j], v[0][j], 0, 1) * wl2 + e0; e0 = __builtin_shufflevector(v[0][j], v[0][j], 2, 3) * wh2 + e0;
                e1 = __builtin_shufflevector(v[1][j], v[1][j], 0, 1) * wl2 + e1; e1 = __builtin_shufflevector(v[1][j], v[1][j], 2, 3) * wh2 + e1;
                e2 = __builtin_shufflevector(v[2][j], v[2][j], 0, 1) * wl2 + e2; e2 = __builtin_shufflevector(v[2][j], v[2][j], 2, 3) * wh2 + e2;
                e3 = __builtin_shufflevector(v[3][j], v[3][j], 0, 1) * wl2 + e3; e3 = __builtin_shufflevector(v[3][j], v[3][j], 2, 3) * wh2 + e3; }
            const float d0 = e0.x + e0.y, d1 = e1.x + e1.y, d2 = e2.x + e2.y, d3 = e3.x + e3.y;
            p[q] = d0; p[8 + q] = d1; p[16 + q] = d2; p[24 + q] = d3; }
        BFLY_STEP(32, 1); BFLY_STEP(16, 2); BFLY_STEP(8, 4); BFLY_STEP(4, 8); BFLY_STEP(2, 16);
        const float tot = p[0] + __shfl_xor(p[0], 32);
        if (lane < 32) Srow0[lane] = tot + bsm[lane & 7];
    }
}
template <bool SMALL, bool XF32, bool QOUT>
__device__ __forceinline__ void norm_phase(Frame& F, const void* xin, const float* g, const float* modsc, const float* modsh, bf16* H, const float* wsm, const float* bsm, float* S) {
    const int gw = F.vcu * NWAVES + F.wave, NGW = F.G * NWAVES, lane = F.lane;
    LAS float* wl = (LAS float*)(F.lds + RING_OFF);
    if (SMALL) { __syncthreads();
        for (int i = F.tid; i < 8 * D / 4; i += NWAVES * 64) { const int q = i >> 8, col = (i & 255) * 4, ln = (col & 511) >> 3, j = 2 * (col >> 9) + ((col & 7) >> 2); ((LAS f32x4*)wl)[(q * 4 + j) * 64 + ln] = ((const f32x4*)wsm)[i]; }
        __syncthreads(); }
    for (int blk = gw; blk < T / 16; blk += NGW) {
        const int row0 = blk * 16, b = row0 / SEQ;
        f32x4 gs[4], shv[4];
#pragma unroll
        for (int j = 0; j < 4; ++j) { const int col = 8 * lane + 512 * (j >> 1) + 4 * (j & 1); const f32x4 gv = *(const f32x4*)(g + col), sc = *(const f32x4*)(modsc + b * 6144 + col);
            gs[j] = gv * (sc + 1.f); shv[j] = *(const f32x4*)(modsh + b * 6144 + col); }
        bf16* Hb = QOUT ? (bf16*)((signed char*)H + (size_t)row0 * D) : H + (size_t)row0 * D; float* Sb = S + (size_t)row0 * 8;
        v4u raw_n[4][2];
#define NORM_RAW(bt_) do { _Pragma("unroll") for (int r = 0; r < 4; ++r) _Pragma("unroll") for (int j = 0; j < 2; ++j) \
            raw_n[r][j] = *(const GAS v4u*)((const bf16*)xin + ((size_t)row0 + 4 * (bt_) + r) * D + 8 * lane + 512 * j); } while (0)
        if (!XF32) NORM_RAW(0);
        for (int bt = 0; bt < 4; ++bt) {
            f32x4 va[4][4];
            if (XF32) norm_load<true>(va, xin, (size_t)row0 + 4 * bt, lane);
            else {
#pragma unroll
                for (int r = 0; r < 4; ++r)
#pragma unroll
                    for (int j = 0; j < 2; ++j) { const v4u x = raw_n[r][j];
                        va[r][2 * j] = (f32x4){bflo(x.x), bfhi(x.x), bflo(x.y), bfhi(x.y)}; va[r][2 * j + 1] = (f32x4){bflo(x.z), bfhi(x.z), bflo(x.w), bfhi(x.w)}; }
                if (bt < 3) NORM_RAW(bt + 1);
            }
            if (XF32) {
#pragma unroll
                for (int r = 0; r < 4; ++r)
#pragma unroll
                    for (int j = 0; j < 2; ++j) { v4u o; o.x = pk2(va[r][2 * j].x, va[r][2 * j].y); o.y = pk2(va[r][2 * j].z, va[r][2 * j].w); o.z = pk2(va[r][2 * j + 1].x, va[r][2 * j + 1].y); o.w = pk2(va[r][2 * j + 1].z, va[r][2 * j + 1].w);
                        *(GAS v4u*)(F.XB + ((size_t)row0 + 4 * bt + r) * D + 8 * lane + 512 * j) = o; }
            }
            int wo = 0; asm volatile("" : "+v"(wo));
            norm_batch<SMALL, QOUT>(va, gs, shv, QOUT ? (bf16*)((signed char*)Hb + (size_t)bt * 4 * D) : Hb + (size_t)bt * 4 * D, wl + wo, bsm, Sb + bt * 32, lane, F.SA + row0 + 4 * bt);
        }
    }
}
__device__ __forceinline__ void final_norm(Frame& F) {
    const int gw = F.vcu * NWAVES + F.wave, NGW = F.G * NWAVES, lane = F.lane;
    f32x4 gs[4];
#pragma unroll
    for (int j = 0; j < 4; ++j) gs[j] = *(const f32x4*)(F.g_final + 8 * lane + 512 * (j >> 1) + 4 * (j & 1));
    const int nT1 = __builtin_amdgcn_readfirstlane(F.NT[1]);
    const bool tail = MOE_TAIL && F.G == 256 && nT1 > 128;
    const int R1 = nT1 * 4 - 2 * F.G, S1 = tail ? pg8::tail_slices(R1, F.G, MOE_DOWN_KT, PART_SLOTS) : 1, P0 = tail ? __builtin_amdgcn_readfirstlane(F.TILES[(MAXTILES + 128) * 4 + 1]) : T;
    const float* gbase = F.MOD + 4 * 6144 + 5120 + 8 * lane;
#define FIN_D0ROW(p_) ((p_) < D0_SPLIT ? F.D0A + (size_t)(p_) * D : F.D0B + (size_t)((p_) - D0_SPLIT) * D)
    for (int blk = gw; blk < T / 16; blk += NGW) {
        const int pv_ = lane < 16 ? F.POS0[blk * 16 + lane] : (lane < 32 ? F.POS1[blk * 16 + lane - 16] : 0);
        f32x4 gt[4];
#pragma unroll
        for (int j = 0; j < 4; ++j) gt[j] = *(const f32x4*)(gbase + (size_t)(blk >> 9) * 6144 + 512 * (j >> 1) + 4 * (j & 1)) * (1.f / F8_DS);
        v4u raw_n[4][2]; v2u raw_d[4][2][2];
#define FIN_RAW(bt_) do { _Pragma("unroll") for (int r = 0; r < 4; ++r) { const int p0_ = __builtin_amdgcn_readlane(pv_, 4 * (bt_) + r), p1_ = __builtin_amdgcn_readlane(pv_, 16 + 4 * (bt_) + r); \
            const bf16* x_ = F.XB + ((size_t)blk * 16 + 4 * (bt_) + r) * D; const signed char* a_ = (const signed char*)F.D0A + (size_t)p0_ * D; const signed char* b_ = (const signed char*)F.D1 + (size_t)(p1_ < P0 ? p1_ : 0) * D; \
            _Pragma("unroll") for (int j = 0; j < 2; ++j) { raw_n[r][j] = *(const GAS v4u*)(x_ + 8 * lane + 512 * j); raw_d[r][0][j] = *(const GAS v2u*)(a_ + 8 * lane + 512 * j); raw_d[r][1][j] = *(const GAS v2u*)(b_ + 8 * lane + 512 * j); } } } while (0)
        FIN_RAW(0);
#pragma unroll 1
        for (int bt = 0; bt < 4; ++bt) { f32x4 va[4][4]; const size_t row = (size_t)blk * 16 + 4 * bt; int p1r[4];
#pragma unroll
            for (int r = 0; r < 4; ++r) { p1r[r] = __builtin_amdgcn_readlane(pv_, 16 + 4 * bt + r);
#pragma unroll
                for (int j = 0; j < 2; ++j) { const v4u x = raw_n[r][j]; const v2u a = raw_d[r][0][j], b = raw_d[r][1][j];
                    va[r][2 * j] = (f32x4){bflo(x.x), bfhi(x.x), bflo(x.y), bfhi(x.y)} + gt[2 * j] * (fp8x4_f(a.x) + fp8x4_f(b.x));
                    va[r][2 * j + 1] = (f32x4){bflo(x.z), bfhi(x.z), bflo(x.w), bfhi(x.w)} + gt[2 * j + 1] * (fp8x4_f(a.y) + fp8x4_f(b.y)); } }
            if (bt < 3) FIN_RAW(bt + 1);
            float s_[4];
#pragma unroll
            for (int r = 0; r < 4; ++r) { s_[r] = 0.f;
#pragma unroll
                for (int j = 0; j < 4; ++j) s_[r] += (va[r][j].x * va[r][j].x + va[r][j].y * va[r][j].y) + (va[r][j].z * va[r][j].z + va[r][j].w * va[r][j].w); }
#pragma unroll
            for (int r = 0; r < 4; ++r) s_[r] = wave_sum_dpp(s_[r]);
#pragma unroll
            for (int r = 0; r < 4; ++r) { const float rstd = __builtin_amdgcn_rsqf(s_[r] * (1.f / D) + EPS);
                if (p1r[r] < P0) {
#pragma unroll
                    for (int j = 0; j < 4; ++j) *(GAS f32x4*)(F.out + (row + r) * D + 8 * lane + 512 * (j >> 1) + 4 * (j & 1)) = va[r][j] * rstd * gs[j]; } } }
    }
    if (tail) {
        for (int i = gw; i < T - P0; i += NGW) {
            const int pos = P0 + i, tok = __builtin_amdgcn_readfirstlane(F.PERM[T + pos]); const float pwv = F.PW[T + pos];
            const int pos0 = __builtin_amdgcn_readfirstlane(F.POS0[tok]);
            int t = 128; while (t + 1 < nT1 && pos >= __builtin_amdgcn_readfirstlane(F.TILES[(MAXTILES + t + 1) * 4 + 1])) ++t;
            const int rl = pos - __builtin_amdgcn_readfirstlane(F.TILES[(MAXTILES + t) * 4 + 1]);
            const float* gp = F.MOD + 4 * 6144 + (size_t)(tok >> 13) * 6144 + 5120;
            f32x4 va[4], da[4];
#pragma unroll
            for (int j = 0; j < 2; ++j) { const v4u x = *(const GAS v4u*)(F.XB + (size_t)tok * D + 8 * lane + 512 * j); const v2u a = *(const GAS v2u*)((const signed char*)F.D0A + (size_t)pos0 * D + 8 * lane + 512 * j);
                va[2 * j] = (f32x4){bflo(x.x), bfhi(x.x), bflo(x.y), bfhi(x.y)}; va[2 * j + 1] = (f32x4){bflo(x.z), bfhi(x.z), bflo(x.w), bfhi(x.w)};
                da[2 * j] = fp8x4_f(a.x) * (1.f / F8_DS); da[2 * j + 1] = fp8x4_f(a.y) * (1.f / F8_DS); }
#pragma unroll
            for (int jh = 0; jh < 2; ++jh) {
                f32x4 pk[2][11];
#pragma unroll
                for (int jj = 0; jj < 2; ++jj) { const int j = 2 * jh + jj, col = 8 * lane + 512 * (j >> 1) + 4 * (j & 1), pn = col >> 8, cc = col & 255;
                    const float* pp = F.PART + ((size_t)((t - 128) * 4 + pn) * S1) * 65536 + (size_t)rl * 256 + cc;
#pragma unroll
                    for (int k = 0; k < 11; ++k) { pk[jj][k] = zero4(); if (k < S1) pk[jj][k] = *(const f32x4*)(pp + (size_t)k * 65536); } }
#pragma unroll
                for (int jj = 0; jj < 2; ++jj) { const int j = 2 * jh + jj, col = 8 * lane + 512 * (j >> 1) + 4 * (j & 1); f32x4 sum = pk[jj][0];
#pragma unroll
                    for (int k = 1; k < 11; ++k) sum += pk[jj][k];
                    va[j] += *(const f32x4*)(gp + col) * (da[j] + (pwv * (FP8_MOE ? 1.f / (F8_HS * F8_WS) : 1.f)) * sum); } }
            float s = 0.f;
#pragma unroll
            for (int j = 0; j < 4; ++j) s += (va[j].x * va[j].x + va[j].y * va[j].y) + (va[j].z * va[j].z + va[j].w * va[j].w);
            s = wave_sum(s);
            const float rstd = __builtin_amdgcn_rsqf(s * (1.f / D) + EPS);
#pragma unroll
            for (int j = 0; j < 4; ++j) *(GAS f32x4*)(F.out + (size_t)tok * D + 8 * lane + 512 * (j >> 1) + 4 * (j & 1)) = va[j] * rstd * gs[j];
        }
    }
}

__device__ __forceinline__ void lru_scan(Frame& F) {
    for (int gid = blockIdx.x * (NWAVES * 64) + F.tid; gid < NB * 512 * 4; gid += F.G * NWAVES * 64) {
        const int item = gid >> 2, grp = gid & 3, b = item >> 9, ch = item & 511;
        f32x2 cv[16];
#pragma unroll
        for (int i = 0; i < 16; ++i) cv[i] = *(const f32x2*)(F.CAR + (size_t)((b * 64 + 16 * grp + i) * 512 + ch) * 2);
        float ap[16], hl[16], A = 1.f, H = 0.f;
#pragma unroll
        for (int i = 0; i < 16; ++i) { ap[i] = A; hl[i] = H; H = cv[i].x * H + cv[i].y; A *= cv[i].x; }
        const int q0 = F.lane & ~3;
        const float A1 = __shfl(A, q0 + 1), A2 = __shfl(A, q0 + 2), H0 = __shfl(H, q0), H1 = __shfl(H, q0 + 1), H2 = __shfl(H, q0 + 2);
        const float in1 = H0, in2 = A1 * in1 + H1, in3 = A2 * in2 + H2;
        const float hin = grp == 0 ? 0.f : (grp == 1 ? in1 : (grp == 2 ? in2 : in3));
#pragma unroll
        for (int i = 0; i < 16; ++i) F.HIN[(b * 64 + 16 * grp + i) * 512 + ch] = ap[i] * hin + hl[i];
    }
}


typedef short bf16x8 __attribute__((ext_vector_type(8)));
__device__ __forceinline__ f32x4 mma16(bf16x8 a, bf16x8 b, f32x4 c) { return __builtin_amdgcn_mfma_f32_16x16x32_bf16(a, b, c, 0, 0, 0); }
__device__ __forceinline__ bf16x8 ldfrag(const LAS bf16* base, int ld, int r0, int k0, int lane) { return *(const LAS bf16x8*)(base + (r0 + (lane & 15)) * ld + k0 + 8 * (lane >> 4)); }
__device__ __forceinline__ float shfl_up_f(float v, int d) { return __shfl_up(v, d); }

constexpr int ML_NCH = 8, ML_NSG = SEQ / (64 * ML_NCH), ML_UNITS = 16 * ML_NSG;
constexpr int CL_STRIDE = 129 * 128;
__device__ __forceinline__ void mlstm_scan(Frame& F) {
    const int NTH = F.G * NWAVES * 64, g0 = blockIdx.x * (NWAVES * 64) + F.tid;
    float xs[3][ML_NSG];
#pragma unroll
    for (int k = 0; k < 3; ++k) { const int gid = g0 + k * NTH;
        if (gid < 16 * CL_STRIDE) { const int bh = gid / CL_STRIDE, e = gid % CL_STRIDE; const float* p = F.CLOC + (size_t)bh * ML_NSG * CL_STRIDE + e;
#pragma unroll
            for (int sg = 0; sg < ML_NSG; ++sg) xs[k][sg] = p[(size_t)sg * CL_STRIDE]; } }
#pragma unroll
    for (int k = 0; k < 3; ++k) { const int gid = g0 + k * NTH;
        if (gid < 16 * CL_STRIDE) { const int bh = gid / CL_STRIDE, e = gid % CL_STRIDE; float* p = F.CLOC + (size_t)bh * ML_NSG * CL_STRIDE + e;
            float cs = 0.f, m = 0.f;
#pragma unroll
            for (int sg = 0; sg < ML_NSG; ++sg) { const float ml = F.MST[bh * ML_NSG + sg], bt = F.MST[512 + bh * ML_NSG + sg];
                p[(size_t)sg * CL_STRIDE] = cs; if (e == 0) F.MST[1024 + bh * ML_NSG + sg] = m;
                const float mn = fmaxf(bt + m, ml); cs = __expf(bt + m - mn) * cs + __expf(ml - mn) * xs[k][sg]; m = mn; } } }
}

constexpr int LRU_WAVE_BYTES = 6656, LRU_RED_OFF = 8 * LRU_WAVE_BYTES;

typedef short v4i16_t __attribute__((ext_vector_type(4)));
__device__ __forceinline__ bf16x8 ldfrag_tr(const LAS bf16* base, int ld, int k0, int c0, int lane) {
    const int g = lane >> 4, q = (lane & 15) >> 2, p = lane & 3;
    const LAS bf16* a0 = base + (k0 + 8 * g + q) * ld + c0 + 4 * p;
    const v4i16_t lo = __builtin_amdgcn_ds_read_tr16_b64_v4i16((LAS v4i16_t*)a0), hi = __builtin_amdgcn_ds_read_tr16_b64_v4i16((LAS v4i16_t*)(a0 + 4 * ld));
    bf16x8 r; r[0] = lo[0]; r[1] = lo[1]; r[2] = lo[2]; r[3] = lo[3]; r[4] = hi[0]; r[5] = hi[1]; r[6] = hi[2]; r[7] = hi[3]; return r;
}
constexpr int M2_Q = 0, M2_KG = 17408, M2_P = 34816, M2_V = 44032, M2_CT = 63488, M2_TAB = 102400;
template <bool OUT>
__device__ __forceinline__ void mlstm_unit2(Frame& F, int l, int u) {
    const int bh = u / ML_NSG, sg = u % ML_NSG, b = bh >> 2, h = bh & 3;
    int tid_ = F.tid; asm volatile("" : "+v"(tid_));
    const int tid = tid_, lane = tid & 63, w = F.wave, lr = lane & 15, lq = lane >> 4;
    LAS bf16* Qs = (LAS bf16*)(F.lds + M2_Q); LAS bf16* KG = (LAS bf16*)(F.lds + M2_KG); LAS bf16* Vs = (LAS bf16*)(F.lds + M2_V);
    LAS bf16* Ps = (LAS bf16*)(F.lds + M2_P); LAS bf16* CT = (LAS bf16*)(F.lds + M2_CT); LAS float* NUM = (LAS float*)(F.lds + M2_Q);
    LAS float* TAB = (LAS float*)(F.lds + M2_TAB);
    LAS float* pre = TAB; LAS float* gsc = TAB + 192 * ML_NCH; LAS float* tb = gsc + 16; LAS float* sc = tb + 256 * ML_NCH; LAS float* cwl = sc + 16;
    const size_t row0 = (size_t)b * SEQ + 64 * ML_NCH * sg;
    float* cl = F.CLOC + (size_t)u * CL_STRIDE;
    const int mat = tid >> 8, dg = tid & 15, tg = (tid >> 4) & 15, ccol = mat * 512 + h * 128 + 8 * dg;
    float g0 = 0.f, g1 = 0.f;
    if (OUT) { g0 = F.g_mix_out[l * 1024 + h * 128 + 2 * lane]; g1 = F.g_mix_out[l * 1024 + h * 128 + 2 * lane + 1]; }
    f32x4 Cacc[9];
    __syncthreads();
    for (int i = tid; i < 1280; i += NWAVES * 64) { const int mm = i / 640, jj = (i % 640) >> 7, d = i & 127;
        cwl[i] = -1.4426950408889634f * (jj < 4 ? F.w_conv_qk[l * 4096 + jj * 1024 + mm * 512 + h * 128 + d] : F.b_conv_qk[l * 1024 + mm * 512 + h * 128 + d]); }
    if (tid < 192) { const int t = tid / 3, c8 = tid % 3; *(LAS v4u*)(Vs + t * 152 + 128 + 8 * c8) = (v4u){c8 == 0 ? 0x3f80u : 0u, 0u, 0u, 0u}; }
    if (w < ML_NCH) { const size_t rg = row0 + 64 * w + lane;
        const float ig = F.G8[rg * 8 + h], lf = logsigmoid_f(F.G8[rg * 8 + 4 + h]);
        float bb = lf;
#define M2_SCAN64(OP, v_) asm volatile("s_nop 1\n\t" OP " %0, %0, %0 row_shr:1 row_mask:0xf bank_mask:0xf\n\ts_nop 1\n\t" OP " %0, %0, %0 row_shr:2 row_mask:0xf bank_mask:0xf\n\ts_nop 1\n\t" \
            OP " %0, %0, %0 row_shr:4 row_mask:0xf bank_mask:0xf\n\ts_nop 1\n\t" OP " %0, %0, %0 row_shr:8 row_mask:0xf bank_mask:0xf\n\ts_nop 1\n\t" \
            OP " %0, %0, %0 row_bcast:15 row_mask:0xa bank_mask:0xf\n\ts_nop 1\n\t" OP " %0, %0, %0 row_bcast:31 row_mask:0xc bank_mask:0xf" : "+v"(v_))
        M2_SCAN64("v_add_f32_dpp", bb);
        const float cv = ig - bb; float pm = cv;
        M2_SCAN64("v_max_f32_dpp", pm);
#undef M2_SCAN64
        pre[(w * 3 + 0) * 64 + lane] = bb; pre[(w * 3 + 1) * 64 + lane] = cv; pre[(w * 3 + 2) * 64 + lane] = pm;
        if (lane == 63) { gsc[2 * w] = bb; gsc[2 * w + 1] = pm; } }
    if (OUT) {
#pragma unroll
        for (int nt = 0; nt < 8; ++nt) { f32x4 c4;
#pragma unroll
            for (int i = 0; i < 4; ++i) c4[i] = cl[(16 * w + 4 * lq + i) * 128 + 16 * nt + lr];
            Cacc[nt] = c4;
            v2u pk; pk.x = pg8::cvt_pk_bf16(c4[0], c4[1]); pk.y = pg8::cvt_pk_bf16(c4[2], c4[3]); *(LAS v2u*)(CT + (16 * nt + lr) * 152 + 16 * w + 4 * lq) = pk; }
        { const float nv = (lq == 0) ? cl[128 * 128 + 16 * w + lr] : 0.f; Cacc[8] = (f32x4){nv, 0.f, 0.f, 0.f};
          v2u pk; pk.x = pg8::cvt_pk_bf16(nv, 0.f); pk.y = 0u; *(LAS v2u*)(CT + (16 * w + lr) * 152 + 128 + 4 * lq) = pk; }
    } else {
#pragma unroll
        for (int nt = 0; nt < 9; ++nt) Cacc[nt] = zero4();
    }
    v4u xr[7], xv[2];
#define M2_FETCH(jc) do { const size_t rc_ = row0 + 64 * (jc); const int p0_ = 64 * ML_NCH * sg + 64 * (jc); \
        if (OUT || mat == 1) { _Pragma("unroll") for (int i = 0; i < 7; ++i) { const int p = p0_ + 4 * tg - 3 + i; \
            xr[i] = (p >= 0) ? *(const v4u*)(F.Z + (rc_ + 4 * tg - 3 + i) * NZ + ccol) : (v4u){0u, 0u, 0u, 0u}; } } \
        _Pragma("unroll") for (int hh = 0; hh < 2; ++hh) xv[hh] = *(const v4u*)(F.Z + (rc_ + (tid >> 3)) * NZ + 1024 + h * 128 + 8 * ((tid & 7) + 8 * hh)); } while (0)
    M2_FETCH(0);
    __syncthreads();
    if (w < ML_NCH) {
        float m = OUT ? F.MST[1024 + u] : -1e30f, btot = 0.f;
        for (int c = 0; c < w; ++c) { const float bl = gsc[2 * c], pl = gsc[2 * c + 1]; m = fmaxf(bl + m, bl + pl); btot += bl; }
        const float bl = gsc[2 * w], pl = gsc[2 * w + 1], m_new = fmaxf(bl + m, bl + pl);
        const float bb = pre[(w * 3 + 0) * 64 + lane], cv = pre[(w * 3 + 1) * 64 + lane], pm = pre[(w * 3 + 2) * 64 + lane];
        const float mt_ = bb + fmaxf(m, pm);
        tb[(w * 4 + 0) * 64 + lane] = __expf(bb - mt_ - bl + m_new);
        tb[(w * 4 + 1) * 64 + lane] = __expf(bl + cv - m_new);
        tb[(w * 4 + 2) * 64 + lane] = __expf(bb + m - mt_);
        tb[(w * 4 + 3) * 64 + lane] = __expf(-mt_);
        if (lane == 0) { sc[w] = __expf(bl + m - m_new); if (w == ML_NCH - 1) { sc[8] = m_new; sc[9] = btot + bl; } }
    }
    for (int j = 0; j < ML_NCH; ++j) {
        const size_t rc = row0 + 64 * j;
        __syncthreads();
        if (OUT || mat == 1) {
            f32x4 cwa[5], cwb[5];
#pragma unroll
            for (int jj = 0; jj < 5; ++jj) { cwa[jj] = *(const LAS f32x4*)(cwl + (mat * 5 + jj) * 128 + 8 * dg); cwb[jj] = *(const LAS f32x4*)(cwl + (mat * 5 + jj) * 128 + 8 * dg + 4); }
#pragma unroll
            for (int tt = 0; tt < 4; ++tt) { f32x2 o[4];
                o[0] = __builtin_shufflevector(cwa[4], cwa[4], 0, 1); o[1] = __builtin_shufflevector(cwa[4], cwa[4], 2, 3); o[2] = __builtin_shufflevector(cwb[4], cwb[4], 0, 1); o[3] = __builtin_shufflevector(cwb[4], cwb[4], 2, 3);
#pragma unroll
                for (int jj = 0; jj < 4; ++jj) { const v4u x = xr[tt + jj];
                    o[0] = __builtin_shufflevector(cwa[jj], cwa[jj], 0, 1) * (f32x2){bflo(x.x), bfhi(x.x)} + o[0]; o[1] = __builtin_shufflevector(cwa[jj], cwa[jj], 2, 3) * (f32x2){bflo(x.y), bfhi(x.y)} + o[1];
                    o[2] = __builtin_shufflevector(cwb[jj], cwb[jj], 0, 1) * (f32x2){bflo(x.z), bfhi(x.z)} + o[2]; o[3] = __builtin_shufflevector(cwb[jj], cwb[jj], 2, 3) * (f32x2){bflo(x.w), bfhi(x.w)} + o[3]; }
                const float scl = -0.6931471805599453f * (mat ? 0.08838834764831845f * tb[(j * 4 + 1) * 64 + 4 * tg + tt] : 1.f); const f32x2 scl2 = {scl, scl};
                unsigned pkw[4];
#pragma unroll
                for (int e = 0; e < 4; ++e) { const f32x2 den = (f32x2){__builtin_amdgcn_exp2f(o[e].x), __builtin_amdgcn_exp2f(o[e].y)} + (f32x2){1.f, 1.f};
                    const f32x2 res = (o[e] * scl2) * (f32x2){__builtin_amdgcn_rcpf(den.x), __builtin_amdgcn_rcpf(den.y)}; pkw[e] = pg8::cvt_pk_bf16(res.x, res.y); }
                v4u pk; pk.x = pkw[0]; pk.y = pkw[1]; pk.z = pkw[2]; pk.w = pkw[3];
                *(LAS v4u*)((mat ? KG : Qs) + (4 * tg + tt) * 136 + 8 * dg) = pk;
                __builtin_amdgcn_sched_barrier(0); }
        }
        { const int t = tid >> 3;
#pragma unroll
          for (int hh = 0; hh < 2; ++hh) *(LAS v4u*)(Vs + t * 152 + 8 * ((tid & 7) + 8 * hh)) = xv[hh]; }
        __builtin_amdgcn_sched_barrier(0);
        if (j < ML_NCH - 1) M2_FETCH(j + 1);
        __syncthreads();
        if (OUT) {
            { const int ms = w & 3;
              bf16x8 ak[4];
#pragma unroll
              for (int ks = 0; ks < 4; ++ks) ak[ks] = ldfrag(KG, 136, 16 * ms, 32 * ks, lane);
#pragma unroll
              for (int jn = 0; jn < 2; ++jn) { const int nt = 2 * (w >> 2) + jn;
                  f32x4 s = zero4();
                  if (ms <= nt) {
#pragma unroll
                      for (int ks = 0; ks < 4; ++ks) s = mma16(ak[ks], ldfrag(Qs, 136, 16 * nt, 32 * ks, lane), s);
                  }
                  const int t = 16 * nt + lr, s0 = 16 * ms + 4 * lq; const float rf = tb[(j * 4 + 0) * 64 + t];
                  v2u pk; pk.x = pg8::cvt_pk_bf16(s0 <= t ? s[0] * rf : 0.f, s0 + 1 <= t ? s[1] * rf : 0.f); pk.y = pg8::cvt_pk_bf16(s0 + 2 <= t ? s[2] * rf : 0.f, s0 + 3 <= t ? s[3] * rf : 0.f);
                  *(LAS v2u*)(Ps + t * 72 + s0) = pk; } }
            __syncthreads();
        }
        f32x4 accD[5]; const int mtD = w & 3, ntb = 4 * (w >> 2), ntn = 4 + (w >> 2);
        unsigned ov8[8];
        if (OUT) {
#pragma unroll
            for (int r = 0; r < 8; ++r) ov8[r] = *(const unsigned*)(F.Z + (rc + 8 * w + r) * NZ + 1536 + h * 128 + 2 * lane);
            bf16x8 aq[4], ap[2];
#pragma unroll
            for (int ks = 0; ks < 4; ++ks) aq[ks] = ldfrag(Qs, 136, 16 * mtD, 32 * ks, lane);
#pragma unroll
            for (int ks = 0; ks < 2; ++ks) ap[ks] = ldfrag(Ps, 72, 16 * mtD, 32 * ks, lane);
            float is4[4];
#pragma unroll
            for (int i = 0; i < 4; ++i) is4[i] = tb[(j * 4 + 2) * 64 + 16 * mtD + 4 * lq + i];
#pragma unroll
            for (int jn = 0; jn < 5; ++jn) { f32x4 a4 = zero4();
                if (jn < ntn) { const int nt = ntb + jn;
                    __builtin_amdgcn_sched_barrier(0);
#pragma unroll
                    for (int ks = 0; ks < 4; ++ks) a4 = mma16(aq[ks], ldfrag_tr(CT, 152, 32 * ks, 16 * nt, lane), a4);
                    a4[0] *= is4[0]; a4[1] *= is4[1]; a4[2] *= is4[2]; a4[3] *= is4[3];
#pragma unroll
                    for (int ks = 0; ks < 2; ++ks) a4 = mma16(ap[ks], ldfrag_tr(Vs, 152, 32 * ks, 16 * nt, lane), a4); }
                accD[jn] = a4; }
        }
        { const float a = sc[j];
          bf16x8 av[2];
#pragma unroll
          for (int ks = 0; ks < 2; ++ks) av[ks] = ldfrag_tr(Vs, 152, 32 * ks, 16 * w, lane);
#pragma unroll
          for (int nt = 0; nt < 8; ++nt) { f32x4 c4 = Cacc[nt] * a;
#pragma unroll
              for (int ks = 0; ks < 2; ++ks) c4 = mma16(av[ks], ldfrag_tr(KG, 136, 32 * ks, 16 * nt, lane), c4);
              Cacc[nt] = c4; }
          { f32x4 c4 = Cacc[8] * a;
#pragma unroll
            for (int ks = 0; ks < 2; ++ks) c4 = mma16(ldfrag_tr(Vs, 152, 32 * ks, 128, lane), ldfrag_tr(KG, 136, 32 * ks, 16 * w, lane), c4);
            Cacc[8] = c4; } }
        if (OUT) {
            __syncthreads();
#pragma unroll
            for (int jn = 0; jn < 5; ++jn) if (jn < ntn) {
#pragma unroll
                for (int i = 0; i < 4; ++i) NUM[(16 * mtD + 4 * lq + i) * 148 + 16 * (ntb + jn) + lr] = accD[jn][i]; }
#pragma unroll
            for (int nt = 0; nt < 8; ++nt) { const f32x4 c4 = Cacc[nt]; v2u pk; pk.x = pg8::cvt_pk_bf16(c4[0], c4[1]); pk.y = pg8::cvt_pk_bf16(c4[2], c4[3]); *(LAS v2u*)(CT + (16 * nt + lr) * 152 + 16 * w + 4 * lq) = pk; }
            { const f32x4 c4 = Cacc[8]; v2u pk; pk.x = pg8::cvt_pk_bf16(c4[0], c4[1]); pk.y = pg8::cvt_pk_bf16(c4[2], c4[3]); *(LAS v2u*)(CT + (16 * w + lr) * 152 + 128 + 4 * lq) = pk; }
            __syncthreads();
            const float dnl_ = __builtin_amdgcn_rcpf(fmaxf(fabsf(NUM[(8 * w + (lane & 7)) * 148 + 128]), tb[(j * 4 + 3) * 64 + 8 * w + (lane & 7)]));
#pragma unroll
            for (int r = 0; r < 8; ++r) { const int t = 8 * w + r;
                const f32x2 nv = *(const LAS f32x2*)(NUM + t * 148 + 2 * lane); const float dn = __builtin_bit_cast(float, __builtin_amdgcn_readlane(__builtin_bit_cast(int, dnl_), r));
                const float h0 = nv.x * dn, h1 = nv.y * dn;
                const float ss = wave_sum_dpp(h0 * h0 + h1 * h1);
                const float rstd = __builtin_amdgcn_rsqf(ss * (1.f / 128.f) + EPS);
                const unsigned ov = ov8[r];
                *(unsigned*)(F.HB + (rc + t) * D + h * 128 + 2 * lane) = pk2(h0 * rstd * g0 * __builtin_amdgcn_rcpf(1.f + __builtin_amdgcn_exp2f(bflo(ov))), h1 * rstd * g1 * __builtin_amdgcn_rcpf(1.f + __builtin_amdgcn_exp2f(bfhi(ov)))); }
        }
    }
    if (!OUT) {
#pragma unroll
        for (int nt = 0; nt < 8; ++nt)
#pragma unroll
            for (int i = 0; i < 4; ++i) cl[(16 * w + 4 * lq + i) * 128 + 16 * nt + lr] = Cacc[nt][i];
        if (lq == 0) cl[128 * 128 + 16 * w + lr] = Cacc[8][0];
        if (tid == 0) { F.MST[u] = sc[8]; F.MST[512 + u] = sc[9]; }
    }
#undef M2_FETCH
}

#define LRU_SCAN_STEP(N_) do { asm volatile("s_nop 1" ::: "memory"); _Pragma("unroll") for (int e_ = 0; e_ < 16; ++e_) { \
        asm volatile("v_fmac_f32_dpp %0, %0, %1 row_shr:" #N_ " row_mask:0xf bank_mask:0xf" : "+v"(Us[e_]) : "v"(As[e_])); \
        asm volatile("v_mul_f32_dpp %0, %0, %0 row_shr:" #N_ " row_mask:0xf bank_mask:0xf" : "+v"(As[e_])); } } while (0)
__device__ __forceinline__ float row_bcast15_nn(float v) { float r; asm volatile("v_mov_b32_dpp %0, %1 row_newbcast:15 row_mask:0xf bank_mask:0xf" : "=v"(r) : "v"(v)); return r; }
__device__ __forceinline__ float row_bcast15(float v) { float r; asm volatile("s_nop 1\n\tv_mov_b32_dpp %0, %1 row_newbcast:15 row_mask:0xf bank_mask:0xf" : "=v"(r) : "v"(v)); return r; }
template <bool OUT>
__device__ __forceinline__ void lru2(Frame& F, int l) {
    const int lane = F.lane, n = F.wave, lr = lane & 15, lq = lane >> 4;
    LAS float* XC = (LAS float*)(F.lds + n * LRU_WAVE_BYTES);
    LAS float* CW = XC + 16 * 68;
    LAS float* CN = CW + 320;
    LAS float* red = (LAS float*)(F.lds + LRU_RED_OFF);
    bf16* LU = F.ASORT;
    __syncthreads();
    CN[192 + lane] = F.g_mix_out[l * 1024 + 512 + 64 * n + lane];
    bf16x8 fa[4][2], fx[4][2];
    if (!OUT) {
#pragma unroll
        for (int j = 0; j < 4; ++j) CW[j * 64 + lane] = F.w_conv_lru[l * 2048 + j * 512 + 64 * n + lane];
        CW[256 + lane] = F.b_conv_lru[l * 512 + 64 * n + lane];
        const float NL2E = -1.4426950408889634f;
        CN[lane] = NL2E * F.b_lru_a[l * 512 + 64 * n + lane]; CN[64 + lane] = NL2E * F.b_lru_x[l * 512 + 64 * n + lane];
        CN[128 + lane] = 8.f * NL2E * softplus_f(-F.lru_lambda[l * 512 + 64 * n + lane]);
        const float* WA = F.w_lru_a + (size_t)l * 8 * 4096 + n * 4096; const float* WX = F.w_lru_x + (size_t)l * 8 * 4096 + n * 4096;
#pragma unroll
        for (int mt = 0; mt < 4; ++mt)
#pragma unroll
            for (int ks = 0; ks < 2; ++ks) { const int e = 16 * mt + lr, d0 = 32 * ks + 8 * lq; v4u pa, px;
                pa.x = pk2(NL2E * WA[(d0 + 0) * 64 + e], NL2E * WA[(d0 + 1) * 64 + e]); pa.y = pk2(NL2E * WA[(d0 + 2) * 64 + e], NL2E * WA[(d0 + 3) * 64 + e]); pa.z = pk2(NL2E * WA[(d0 + 4) * 64 + e], NL2E * WA[(d0 + 5) * 64 + e]); pa.w = pk2(NL2E * WA[(d0 + 6) * 64 + e], NL2E * WA[(d0 + 7) * 64 + e]);
                px.x = pk2(NL2E * WX[(d0 + 0) * 64 + e], NL2E * WX[(d0 + 1) * 64 + e]); px.y = pk2(NL2E * WX[(d0 + 2) * 64 + e], NL2E * WX[(d0 + 3) * 64 + e]); px.z = pk2(NL2E * WX[(d0 + 4) * 64 + e], NL2E * WX[(d0 + 5) * 64 + e]); px.w = pk2(NL2E * WX[(d0 + 6) * 64 + e], NL2E * WX[(d0 + 7) * 64 + e]);
                fa[mt][ks] = __builtin_bit_cast(bf16x8, pa); fx[mt][ks] = __builtin_bit_cast(bf16x8, px); }
    }
    for (int u = blockIdx.x; u < 256; u += F.G) {
        const int b = u >> 6, sg = u & 63, s0 = 128 * sg;
        const size_t row0 = (size_t)b * SEQ + s0;
        float hst[16], atot[16];
#pragma unroll
        for (int e = 0; e < 16; ++e) { hst[e] = OUT ? F.HIN[(b * 64 + sg) * 512 + 64 * n + 16 * (e >> 2) + 4 * lq + (e & 3)] : 0.f; atot[e] = 1.f; }
        v4u lu_n[4], xc_n[8]; v2u gl_n[4];
#define LRU_FETCH(tau_) do { const size_t rt_ = row0 + 16 * (tau_); \
            if (OUT) { _Pragma("unroll") for (int mt = 0; mt < 4; ++mt) { lu_n[mt] = *(const v4u*)(LU + ((rt_ + lr) * 512 + 64 * n + 16 * mt + 4 * lq) * 2); gl_n[mt] = *(const v2u*)(F.Z + (rt_ + lr) * NZ + 2560 + 64 * n + 16 * mt + 4 * lq); } } \
            else { const int t_ = lane >> 2, cg_ = lane & 3, p_ = s0 + 16 * (tau_) + t_; \
                _Pragma("unroll") for (int j = 0; j < 4; ++j) { const bf16* zp = F.Z + (rt_ + t_ - 3 + j) * NZ + 2048 + 64 * n + 16 * cg_; const bool ok_ = p_ - 3 + j >= 0; \
                    xc_n[2 * j] = ok_ ? *(const v4u*)zp : (v4u){0u, 0u, 0u, 0u}; xc_n[2 * j + 1] = ok_ ? *(const v4u*)(zp + 8) : (v4u){0u, 0u, 0u, 0u}; } } } while (0)
        LRU_FETCH(0);
        for (int tau = 0; tau < 8; ++tau) {
            const size_t rt = row0 + 16 * tau;
            float As[16], Us[16];
            v2u glv[4]; v4u lu[4], xcv[8];
#pragma unroll
            for (int mt = 0; mt < 4; ++mt) { lu[mt] = lu_n[mt]; glv[mt] = gl_n[mt]; }
#pragma unroll
            for (int q = 0; q < 8; ++q) xcv[q] = xc_n[q];
            if (tau < 7) LRU_FETCH(tau + 1);
            if (OUT) {
#pragma unroll
                for (int mt = 0; mt < 4; ++mt) { const unsigned wv[4] = {lu[mt].x, lu[mt].y, lu[mt].z, lu[mt].w};
#pragma unroll
                    for (int i = 0; i < 4; ++i) { As[4 * mt + i] = __builtin_amdgcn_exp2f(bflo(wv[i])); Us[4 * mt + i] = bfhi(wv[i]); } }
            } else {
                { const int t = lane >> 2, cg = lane & 3;
                  f32x4 o0 = *(const LAS f32x4*)(CW + 256 + 16 * cg), o1 = *(const LAS f32x4*)(CW + 256 + 16 * cg + 4), o2 = *(const LAS f32x4*)(CW + 256 + 16 * cg + 8), o3 = *(const LAS f32x4*)(CW + 256 + 16 * cg + 12);
#pragma unroll
                  for (int j = 0; j < 4; ++j) { {
                      const v4u x0 = xcv[2 * j], x1 = xcv[2 * j + 1];
                      const f32x4 w0 = *(const LAS f32x4*)(CW + j * 64 + 16 * cg), w1 = *(const LAS f32x4*)(CW + j * 64 + 16 * cg + 4), w2 = *(const LAS f32x4*)(CW + j * 64 + 16 * cg + 8), w3 = *(const LAS f32x4*)(CW + j * 64 + 16 * cg + 12);
                      o0 += w0 * (f32x4){bflo(x0.x), bfhi(x0.x), bflo(x0.y), bfhi(x0.y)}; o1 += w1 * (f32x4){bflo(x0.z), bfhi(x0.z), bflo(x0.w), bfhi(x0.w)};
                      o2 += w2 * (f32x4){bflo(x1.x), bfhi(x1.x), bflo(x1.y), bfhi(x1.y)}; o3 += w3 * (f32x4){bflo(x1.z), bfhi(x1.z), bflo(x1.w), bfhi(x1.w)}; } }
                  LAS f32x4* xo = (LAS f32x4*)(XC + t * 68 + 16 * cg); xo[0] = o0; xo[1] = o1; xo[2] = o2; xo[3] = o3; }
                bf16x8 fb[2];
#pragma unroll
                for (int ks = 0; ks < 2; ++ks) { const f32x4 v0 = *(const LAS f32x4*)(XC + lr * 68 + 32 * ks + 8 * lq), v1 = *(const LAS f32x4*)(XC + lr * 68 + 32 * ks + 8 * lq + 4);
                    v4u pb; pb.x = pg8::cvt_pk_bf16(v0.x, v0.y); pb.y = pg8::cvt_pk_bf16(v0.z, v0.w); pb.z = pg8::cvt_pk_bf16(v1.x, v1.y); pb.w = pg8::cvt_pk_bf16(v1.z, v1.w); fb[ks] = __builtin_bit_cast(bf16x8, pb); }
#pragma unroll
                for (int mt = 0; mt < 4; ++mt) {
                    const int e0 = 16 * mt + 4 * lq;
                    const f32x4 sp = *(const LAS f32x4*)(CN + 128 + e0), xc = *(const LAS f32x4*)(XC + lr * 68 + e0);
                    f32x4 R = *(const LAS f32x4*)(CN + e0), I = *(const LAS f32x4*)(CN + 64 + e0);
                    R = mma16(fa[mt][0], fb[0], R); R = mma16(fa[mt][1], fb[1], R); I = mma16(fx[mt][0], fb[0], I); I = mma16(fx[mt][1], fb[1], I);
                    unsigned wv[4];
#pragma unroll
                    for (int i = 0; i < 4; ++i) {
                        const float r = __builtin_amdgcn_rcpf(1.f + __builtin_amdgcn_exp2f(R[i])), ii = __builtin_amdgcn_rcpf(1.f + __builtin_amdgcn_exp2f(I[i]));
                        const float la = r * sp[i], a = __builtin_amdgcn_exp2f(la), uu = __builtin_amdgcn_sqrtf(fmaxf(fmaf(-a, a, 1.f), 0.f)) * (ii * xc[i]);
                        wv[i] = pg8::cvt_pk_bf16(la, uu);
                        As[4 * mt + i] = __builtin_amdgcn_exp2f(bflo(wv[i])); Us[4 * mt + i] = bfhi(wv[i]); }
                    *(v4u*)(LU + ((rt + lr) * 512 + 64 * n + e0) * 2) = (v4u){wv[0], wv[1], wv[2], wv[3]};
                }
            }
            LRU_SCAN_STEP(1); LRU_SCAN_STEP(2); LRU_SCAN_STEP(4); LRU_SCAN_STEP(8);
            float ssq = 0.f, yv[16], hc[16];
#pragma unroll
            for (int e = 0; e < 16; ++e) hc[e] = As[e] * hst[e] + Us[e];
            asm volatile("s_nop 1" : "+v"(hc[0]), "+v"(hc[1]), "+v"(hc[2]), "+v"(hc[3]), "+v"(hc[4]), "+v"(hc[5]), "+v"(hc[6]), "+v"(hc[7]));
            asm volatile("s_nop 1" : "+v"(hc[8]), "+v"(hc[9]), "+v"(hc[10]), "+v"(hc[11]), "+v"(hc[12]), "+v"(hc[13]), "+v"(hc[14]), "+v"(hc[15]));
#pragma unroll
            for (int e = 0; e < 16; ++e) hst[e] = row_bcast15_nn(hc[e]);
            if (!OUT) {
#pragma unroll
                for (int e = 0; e < 16; ++e) atot[e] *= row_bcast15_nn(As[e]);
            } else {
#pragma unroll
                for (int e = 0; e < 16; ++e) { const unsigned gw_ = (e & 2) ? glv[e >> 2].y : glv[e >> 2].x; const float y = hc[e] * gelu_tanh_f((e & 1) ? bfhi(gw_) : bflo(gw_)); yv[e] = y; ssq += y * y; }
            }
            if (OUT) {
                const int buf = tau & 1;
                ssq += __shfl_xor(ssq, 16); ssq += __shfl_xor(ssq, 32);
                if (lane < 16) red[(buf * 16 + lane) * 8 + n] = ssq;
                __syncthreads();
                const f32x4 ra_ = *(const LAS f32x4*)(red + (buf * 16 + lr) * 8), rb_ = *(const LAS f32x4*)(red + (buf * 16 + lr) * 8 + 4);
                const float tot = ((ra_.x + ra_.y) + (ra_.z + ra_.w)) + ((rb_.x + rb_.y) + (rb_.z + rb_.w));
                const float rstd = __builtin_amdgcn_rsqf(tot * (1.f / 512.f) + EPS);
#pragma unroll
                for (int mt = 0; mt < 4; ++mt) { const int e0 = 16 * mt + 4 * lq; const f32x4 gm = *(const LAS f32x4*)(CN + 192 + e0);
                    v2u o; o.x = pg8::cvt_pk_bf16(yv[4 * mt] * rstd * gm[0], yv[4 * mt + 1] * rstd * gm[1]); o.y = pg8::cvt_pk_bf16(yv[4 * mt + 2] * rstd * gm[2], yv[4 * mt + 3] * rstd * gm[3]);
                    *(v2u*)(F.HB + (rt + lr) * D + 512 + 64 * n + e0) = o; }
            }
        }
        if (!OUT && lr == 0) {
#pragma unroll
            for (int e = 0; e < 16; ++e) { const int o = ((b * 64 + sg) * 512 + 64 * n + 16 * (e >> 2) + 4 * lq + (e & 3)) * 2; F.CAR[o] = atot[e]; F.CAR[o + 1] = hst[e]; }
        }
    }
}

__device__ __forceinline__ void route_count(Frame& F) {
    LAS int* lcnt = (LAS int*)(F.lds + RING_OFF);
    asm volatile("s_waitcnt vmcnt(0)" ::: "memory");
    __syncthreads();
    for (int vb = F.vcu; vb < T / 128; vb += F.G) {
        if (F.tid < 32) lcnt[F.tid] = 0;
        __syncthreads();
        if (F.tid < 128) {
            const int tok = vb * 128 + F.tid;
            float lg[8];
#pragma unroll
            for (int j = 0; j < 8; ++j) lg[j] = __hip_atomic_load(F.RL + (size_t)tok * 8 + j, __ATOMIC_RELAXED, __HIP_MEMORY_SCOPE_AGENT);
            int i0 = 0; float v0 = lg[0];
#pragma unroll
            for (int j = 1; j < 8; ++j) if (lg[j] > v0) { v0 = lg[j]; i0 = j; }
            int i1 = -1; float v1 = -3.0e38f;
#pragma unroll
            for (int j = 0; j < 8; ++j) if (j != i0 && lg[j] > v1) { v1 = lg[j]; i1 = j; }
            const float ex = __expf(v1 - v0), p0 = 1.f / (1.f + ex), p1 = ex / (1.f + ex);
            F.TOPI[tok * 2] = i0; F.TOPI[tok * 2 + 1] = i1; F.TOPP[tok * 2] = p0; F.TOPP[tok * 2 + 1] = p1;
            __hip_atomic_fetch_add(&lcnt[i0], 1, __ATOMIC_RELAXED, __HIP_MEMORY_SCOPE_WORKGROUP); __hip_atomic_fetch_add(&lcnt[8 + i1], 1, __ATOMIC_RELAXED, __HIP_MEMORY_SCOPE_WORKGROUP);
            if (i1 == i0 + 1) __hip_atomic_fetch_add(&lcnt[16 + i0], 1, __ATOMIC_RELAXED, __HIP_MEMORY_SCOPE_WORKGROUP);
        }
        __syncthreads();
        if (F.tid < 32) F.CNT[vb * 32 + F.tid] = lcnt[F.tid];
        __syncthreads();
    }
}
__device__ __forceinline__ void route_place(Frame& F) {
    LAS int* ltot = (LAS int*)(F.lds + RING_OFF);
    LAS int* lbef = ltot + 32;
    LAS int* lf = lbef + 32;
    LAS int* loff = lf + 8;
    LAS int* ltp = loff + 16;
    LAS int* li0 = ltp + 16;
    LAS int* li1 = li0 + 128;
    LAS int* leA = li1 + 128;
    LAS int* leB = leA + 128;
    LAS int* lpos = leB + 128;
    LAS int* lred = lpos + 256;
    for (int vb = blockIdx.x; vb < T / 128; vb += F.G) {
        {
          const int c = F.tid & 31, gq = F.tid >> 5; int cv[16];
#pragma unroll
          for (int k = 0; k < 16; ++k) cv[k] = F.CNT[(gq * 16 + k) * 32 + c];
          int tot = 0, bef = 0;
#pragma unroll
          for (int k = 0; k < 16; ++k) { tot += cv[k]; bef += (gq * 16 + k < vb) ? cv[k] : 0; }
          lred[F.tid] = tot; lred[512 + F.tid] = bef;
          __syncthreads();
          if (F.tid < 32) { int t2 = 0, b2 = 0;
#pragma unroll
              for (int q = 0; q < 16; ++q) { t2 += lred[q * 32 + F.tid]; b2 += lred[512 + q * 32 + F.tid]; }
              ltot[F.tid] = t2; lbef[F.tid] = b2; } }
        if (F.tid < 128) { const int tok = vb * 128 + F.tid; li0[F.tid] = F.TOPI[tok * 2]; li1[F.tid] = F.TOPI[tok * 2 + 1]; }
        __syncthreads();
        if (F.tid == 0) {
            int f[8]; bool ok = true; int prev = 0;
            for (int e = 0; e < 7; ++e) { prev = ((ltot[e] & 255) + prev) & 255; f[e] = prev; ok = ok && (prev <= ltot[16 + e]); }
            f[7] = 0;
            if (!ok) for (int e = 0; e < 8; ++e) f[e] = 0;
            int baseA = 0, baseB = 0;
            for (int e = 0; e < 8; ++e) { lf[e] = f[e];
                const int fin = e ? f[e - 1] : 0, totA = ltot[e] - f[e] + fin, totB = ltot[e] + ltot[8 + e] - totA;
                const int outb = e < 7 ? (f[e] < lbef[16 + e] ? f[e] : lbef[16 + e]) : 0, inb = e ? (f[e - 1] < lbef[16 + e - 1] ? f[e - 1] : lbef[16 + e - 1]) : 0;
                const int befA = lbef[e] - outb + inb, befB = lbef[e] + lbef[8 + e] - befA;
                loff[e] = baseA + befA; loff[8 + e] = baseB + befB; ltp[e] = totA; ltp[8 + e] = totB; baseA += totA; baseB += totB; }
        }
        __syncthreads();
        if (F.tid < 128) { const int tt = F.tid, i0 = li0[tt], i1 = li1[tt]; bool sw = false;
            if (i1 == i0 + 1) { int q = 0; for (int j = 0; j < tt; ++j) q += (li0[j] == i0 && li1[j] == i1) ? 1 : 0; sw = (lbef[16 + i0] + q) < lf[i0]; }
            leA[tt] = sw ? i1 : i0; leB[tt] = sw ? i0 : i1; }
        __syncthreads();
        if (F.tid < 256) { const int s = F.tid >> 7, tt = F.tid & 127, tok = vb * 128 + tt; const LAS int* le = s ? leB : leA; const int e = le[tt]; int rank = 0;
            for (int j = 0; j < tt; ++j) rank += (le[j] == e) ? 1 : 0;
            const int pos = loff[s * 8 + e] + rank; const int which = (e == li0[tt]) ? 0 : 1;
            F.PERM[s * T + pos] = tok; F.PW[s * T + pos] = F.TOPP[tok * 2 + which]; lpos[s * 128 + tt] = pos; if (s == 1) F.POS1[tok] = pos; else F.POS0[tok] = pos; }
#if MOE_I8 && GATHER_OVERLAP
        __syncthreads();
#pragma unroll 1
        for (int h8 = 0; h8 < 2; ++h8) { v4u rw[8]; float sc[8];
#pragma unroll
            for (int j = 0; j < 8; ++j) { const int tok = vb * 128 + F.wave + NWAVES * (8 * h8 + j); rw[j] = *((const GAS v4u*)((const signed char*)F.HB8R + (size_t)tok * D) + F.lane); sc[j] = F.SA[tok]; }
#pragma unroll
            for (int j = 0; j < 8; ++j) { const int i = F.wave + NWAVES * (8 * h8 + j), pos0 = lpos[i], pos1 = (T + 256) + lpos[128 + i];
                *((GAS v4u*)((signed char*)F.ASORT + (size_t)pos0 * D) + F.lane) = rw[j]; *((GAS v4u*)((signed char*)F.ASORT + (size_t)pos1 * D) + F.lane) = rw[j];
                if (F.lane == 0) { F.SAS[pos0] = sc[j]; F.SAS[pos1] = sc[j]; } } }
#endif
        if (vb == 0 && F.tid < 2) { const int s = F.tid; int nt = 0, base = 0;
            for (int e = 0; e < NE; ++e) { const int tot = ltp[s * 8 + e];
                for (int i = 0; i * 256 < tot; ++i) { int* tp = F.TILES + (s * MAXTILES + nt) * 4; tp[0] = e; tp[1] = base + 256 * i; tp[2] = (tot - 256 * i) < 256 ? (tot - 256 * i) : 256; tp[3] = 0; ++nt; }
                base += tot; }
            F.NT[s] = nt; }
        __syncthreads();
    }
}
__device__ __forceinline__ void route_gather(Frame& F, int s, int wg, int nwg) {
    const int gw = wg * NWAVES + F.wave, NGW = nwg * NWAVES;
#if MOE_I8
    for (int p0 = gw; p0 < T; p0 += 8 * NGW) {
        int tok[8]; v4u rw[8]; float sc[8];
#pragma unroll
        for (int j = 0; j < 8; ++j) { const int pos = p0 + j * NGW; tok[j] = pos < T ? __builtin_amdgcn_readfirstlane(F.PERM[s * T + pos]) : -1; }
#pragma unroll
        for (int j = 0; j < 8; ++j) if (tok[j] >= 0) { rw[j] = *((const GAS v4u*)((const signed char*)F.HB8R + (size_t)tok[j] * D) + F.lane); sc[j] = F.SA[tok[j]]; }
#pragma unroll
        for (int j = 0; j < 8; ++j) if (tok[j] >= 0) { const int pos = p0 + j * NGW; *((GAS v4u*)((signed char*)F.ASORT + (size_t)pos * D) + F.lane) = rw[j]; if (F.lane == 0) F.SAS[pos] = sc[j]; }
    }
#else
    for (int pos = gw; pos < T; pos += NGW) { const int tok = F.PERM[s * T + pos];
        const GAS v4u* src = (const GAS v4u*)(F.HB + (size_t)tok * D) + F.lane; GAS v4u* dst = (GAS v4u*)(F.ASORT + (size_t)pos * D) + F.lane;
        dst[0] = src[0]; dst[64] = src[64]; }
#endif
}

constexpr int NPH = 26;
struct Args { const float* in[28]; float* out; unsigned char* ws; int ph_lo, ph_hi, dummy; };
__device__ __forceinline__ int opq_(int v) { asm volatile("" : "+s"(v)); return v; }
#define FRAME_PTRS() do { const __attribute__((address_space(4))) Args* ap_ = (const __attribute__((address_space(4))) Args*)__builtin_amdgcn_kernarg_segment_ptr(); asm volatile("" : "+s"(ap_)); \
    unsigned char* ws = ap_->ws; \
    F.ctl = (gu32*)(ws + WS_CTL); \
    F.x = ap_->in[0]; F.c = ap_->in[1]; F.w_ada = ap_->in[2]; F.b_ada = ap_->in[3]; F.g_norm_mix = ap_->in[4]; F.g_norm_ffn = ap_->in[5]; F.w_in = ap_->in[6]; F.w_conv_qk = ap_->in[7]; \
    F.b_conv_qk = ap_->in[8]; F.b_gates = ap_->in[9]; F.w_conv_lru = ap_->in[10]; F.b_conv_lru = ap_->in[11]; F.w_lru_a = ap_->in[12]; F.b_lru_a = ap_->in[13]; F.w_lru_x = ap_->in[14]; \
    F.b_lru_x = ap_->in[15]; F.lru_lambda = ap_->in[16]; F.g_mix_out = ap_->in[17]; F.w_out = ap_->in[18]; F.w_ff_gate = ap_->in[19]; F.w_ff_up = ap_->in[20]; F.w_ff_down = ap_->in[21]; \
    F.w_router = ap_->in[22]; F.b_router = ap_->in[23]; F.w_exp_gate = ap_->in[24]; F.w_exp_up = ap_->in[25]; F.w_exp_down = ap_->in[26]; F.g_final = ap_->in[27]; \
    F.out = ap_->out; \
    F.MOD = (float*)(ws + WS_MOD); F.WG8 = (float*)(ws + WS_WG8); F.WR8 = (float*)(ws + WS_WR8); F.G8 = (float*)(ws + WS_G); F.RL = (float*)(ws + WS_RL); \
    F.TOPI = (int*)(ws + WS_TOPI); F.TOPP = (float*)(ws + WS_TOPP); F.PERM = (int*)(ws + WS_PERM); F.PW = (float*)(ws + WS_PW); F.CNT = (int*)(ws + WS_CNT); F.TILES = (int*)(ws + WS_TILES); F.NT = (int*)(ws + WS_NT); F.POS1 = (int*)(ws + WS_CNT + 256 * KiB); F.POS0 = (int*)(ws + WS_CNT + 384 * KiB); F.D0A = (bf16*)(ws + WS_D0A); F.D0B = (bf16*)(ws + WS_D0B); F.D1 = (bf16*)(ws + WS_D1); F.PART = (float*)(ws + WS_PART); F.HB8F = (bf16*)(ws + WS_HRAW); F.HB8R = (bf16*)(ws + WS_Z); \
    F.CAR = (float*)(ws + WS_CAR); F.HIN = (float*)(ws + WS_HIN); F.HRAW = (float*)(ws + WS_HRAW); F.CLOC = (float*)ap_->out; F.SA = (float*)(ws + WS_MOD + 512 * KiB); F.SAS = (float*)(ws + WS_MOD + 768 * KiB); F.SBF1 = (float*)(ws + WS_HIN + 576 * KiB); F.SBE1 = F.SBF1 + 2 * FF;      F.SBIN = (float*)(ws + WS_HIN + 800 * KiB); F.SBINX = F.SBIN + 2 * NZ + 2048; F.SBFX = (float*)(ws + WS_CNT + 512 * KiB); F.MST = (float*)(ws + WS_HIN + 512 * KiB); \
    F.WIN = (bf16*)(ws + WS_WIN); F.WOUT = (bf16*)(ws + WS_WOUT); F.WF1 = (bf16*)(ws + WS_WF1); F.WF2 = (bf16*)(ws + WS_WF2); F.WE1 = (bf16*)(ws + WS_WE1); F.WE2 = (bf16*)(ws + WS_WE2); \
    F.HB = (bf16*)((unsigned char*)ap_->out + 64 * MiB); F.Z = (bf16*)(ws + WS_Z); F.HID = (bf16*)(ws + WS_Z); F.ASORT = (bf16*)(ws + WS_HRAW); F.XB = (bf16*)(ws + WS_HB); } while (0)
__global__ void __launch_bounds__(NWAVES * 64, 2) skel_fwd(Args args) {
    extern __shared__ __attribute__((aligned(16))) unsigned char lds[];
    Frame F;
    F.lds = (LAS unsigned char*)lds;
    F.MISC = (volatile LAS unsigned*)(F.lds + MISC_OFF);
    F.tid = threadIdx.x; F.lane = F.tid & 63; F.wave = __builtin_amdgcn_readfirstlane(F.tid >> 6); const int wave0_ = F.wave;
    F.G = gridDim.x; { const int bx = blockIdx.x; F.vcu = (F.G % 8 == 0) ? (bx % 8) * (F.G / 8) + bx / 8 : bx; }
    FRAME_PTRS();
    for (int u = F.tid; u < (LDS_BYTES - LDSCTL_OFF) / 4; u += NWAVES * 64) ((LAS unsigned*)(F.lds + LDSCTL_OFF))[u] = 0u;
    __syncthreads();
    XcdBarrier bar; bar.bar = (unsigned*)(F.ctl + CW_BAR); bar.x = 0; bar.st = nullptr; bar.lead = 0;
    if (!MK_PER_PHASE) bar = xcd_barrier_post((unsigned*)(F.ctl + CW_BAR), F.MISC + 8);
    if (!MK_PER_PHASE && threadIdx.x == 0) grp_barrier_post((unsigned*)(F.ctl + CW_BAR), blockIdx.x & 7u, bar.x);
    unsigned grp_gen = 0u; int gl_seen = 0;
    const int lo = args.ph_lo, hi = args.ph_hi;
#define IN(k) (lo <= (k) && (k) < hi)
#define REP(k) for (int rep_ = ([&] { FRAME_PTRS(); }(), 0); rep_ < 1; ++rep_)
#ifdef SPLITMASK
#define RESBUF(k) ((args.dummy && (k) == hi - 1) ? (bf16*)F.out : F.XB)
#else
#define RESBUF(k) F.XB
#endif
#define REFRESH() do { int l_, w_ = wave0_; asm volatile("v_mbcnt_lo_u32_b32 %0, -1, 0\n\tv_mbcnt_hi_u32_b32 %0, -1, %0" : "=v"(l_)); asm volatile("" : "+s"(w_)); F.lane = l_; F.wave = w_; F.tid = 64 * w_ + l_; } while (0)
#ifndef SEAM_DUP
#define SEAM_DUP 0
#endif
#define STAGGER(u_) do { if (EPI_STAGGER) { const int g_ = (int)((blockIdx.x >> 3) & 3); for (int i_ = 0; i_ < g_ * (u_); ++i_) __builtin_amdgcn_s_sleep(64); } } while (0)
#define SEAM(k) do { if (!MK_PER_PHASE && IN(k) && IN((k) + 1)) { xcd_barrier(bar); if (SEAM_DUP) xcd_barrier(bar); gl_seen = 1; } } while (0)
#define SEAM_L(k) do { if (!MK_PER_PHASE && IN(k) && IN((k) + 1)) { if (LOCAL_SEAMS && gl_seen && F.G % 8 == 0 && F.G >= 8) grp_barrier(bar, blockIdx.x & 7u, (++grp_gen) * ((unsigned)F.G >> 3), F.MISC + 10); else { xcd_barrier(bar); gl_seen = 1; } } } while (0)

    if (IN(0)) REP(0) { REFRESH(); p0_prologue(F); quant_weights(F); } SEAM(0);

    for (int l = 0; l < 2; ++l) {
        const int pb = 1 + 9 * l;
        const float* mod = F.MOD + l * 4 * 6144;
        if (IN(pb)) REP(pb) { REFRESH();
            if (l == 0) norm_phase<true, true, IN_I8 != 0>(F, F.x, F.g_norm_mix, mod + 1024, mod, F.HB, F.WG8, F.b_gates, F.G8);
            else norm_phase<true, false, IN_I8 != 0>(F, F.XB, F.g_norm_mix + D, mod + 1024, mod, F.HB, F.WG8 + 8 * D, F.b_gates + 8, F.G8);
            if (l == 0) for (int i = (int)blockIdx.x * (NWAVES * 64) + F.tid; i < 9 * 2 * FF; i += F.G * NWAVES * 64)
                F.SBFX[i] = F.SBF1[i] * (((i & 255) >= 128) ? F8_HS : 1.f);
            if (blockIdx.x == 0) for (int i = F.tid; i < NZ; i += NWAVES * 64) F.SBINX[l * NZ + i] = F.SBIN[l * NZ + i] * ((i >= 1536 && i < 2048) ? -1.4426950408889634f : 1.f); }
        SEAM_L(pb);
#if IN_I8
        if (IN(pb + 1)) REP(pb + 1) { STAGGER(1); pg8::Gemm g{F.HB, (const bf16*)((const signed char*)F.WIN + (size_t)l * NZ * D), T, NZ, D / 2}; pg8::StaticOrder S; S.init(T, NZ, F.G, (int)blockIdx.x); pg8::EpiBf16q E{F.Z, NZ, F.SA, F.SBINX + l * NZ};
            pg8::gemm_phase<pg8::EpiBf16q, pg8::StaticOrder, PG8_ALIGN, PG8_SP2>(F.lds + RING_OFF, g, S, E, F.wave); }
#else
        if (IN(pb + 1)) REP(pb + 1) { pg8::Gemm g{F.HB, F.WIN + (size_t)l * NZ * D, T, NZ, D}; pg8::StaticOrder S; S.init(T, NZ, F.G, (int)blockIdx.x); pg8::EpiBf16 E{F.Z, NZ};
            pg8::gemm_phase<pg8::EpiBf16, pg8::StaticOrder, PG8_ALIGN, PG8_SP2>(F.lds + RING_OFF, g, S, E, F.wave); }
#endif
        SEAM(pb + 1);
        if (IN(pb + 2)) REP(pb + 2) { REFRESH();
            { const int alt_ = opq_(MIX_ALT ? (int)((blockIdx.x >> 3) & 1) : 0);
              if (alt_) { lru2<false>(F, l); __syncthreads(); REFRESH(); }
              for (int u = blockIdx.x; u < ML_UNITS; u += F.G) mlstm_unit2<false>(F, l, u);
              if (!alt_) { __syncthreads(); REFRESH(); lru2<false>(F, l); } }
        }
        SEAM(pb + 2);
        if (IN(pb + 3)) REP(pb + 3) { REFRESH();
            mlstm_scan(F);
            lru_scan(F); }
        SEAM(pb + 3);
        if (IN(pb + 4)) REP(pb + 4) { REFRESH();
            { const int alt_ = opq_(MIX_ALT ? (int)((blockIdx.x >> 3) & 1) : 0);
              if (alt_) { lru2<true>(F, l); __syncthreads(); REFRESH(); }
              for (int u = blockIdx.x; u < ML_UNITS; u += F.G) mlstm_unit2<true>(F, l, u);
              if (!alt_) { __syncthreads(); REFRESH(); lru2<true>(F, l); } }
        }
        SEAM(pb + 4);
        if (IN(pb + 5)) REP(pb + 5) { pg8::Gemm g{F.HB, F.WOUT + (size_t)l * D * D, T, D, D}; pg8::StaticOrder S; S.init(T, D, F.G, (int)blockIdx.x); Gemm2Epi E; E.x = RESBUF(pb + 5); E.gate = mod + 2048; E.osc = 1.f;
            pg8::gemm_phase<Gemm2Epi, pg8::StaticOrder, PG8_ALIGN, PG8_SP2>(F.lds + RING_OFF, g, S, E, F.wave); }
        SEAM_L(pb + 5);
        if (l == 0) {
            if (IN(7)) REP(7) { REFRESH(); norm_phase<false, false, true>(F, F.XB, F.g_norm_ffn, mod + 4096, mod + 3072, F.HB8F, nullptr, nullptr, nullptr); }
            SEAM_L(7);
            if (IN(8)) REP(8) { STAGGER(1); pg8::Gemm g{F.HB8F, F.WF1, T, 2 * FF, D / 2}; pg8::StaticOrder S; S.init(T, 2 * FF, F.G, (int)blockIdx.x); DenseUpEpi E{F.HID, FF, F.SA, F.SBFX, F8_HS};
                pg8::gemm_phase<DenseUpEpi, pg8::StaticOrder, PG8_ALIGN, PG8_SP2>(F.lds + RING_OFF, g, S, E, F.wave); }
            SEAM_L(8);
            if (IN(9)) REP(9) { pg8::Gemm g{F.HID, F.WF2, T, D, FP8_DENSE ? FF / 2 : FF}; pg8::StaticOrder S; S.init(T, D, F.G, (int)blockIdx.x); DenseDownEpi E; E.x = RESBUF(9); E.gate = mod + 5120; E.osc = FP8_DENSE ? 1.f / (F8_HS * F8_WS) : 1.f;
                pg8::gemm_phase<DenseDownEpi, pg8::StaticOrder, PG8_ALIGN, PG8_SP2>(F.lds + RING_OFF, g, S, E, F.wave); }
            SEAM(9);
        } else {
            if (IN(16)) REP(16) { REFRESH(); norm_phase<true, false, MOE_I8 != 0>(F, F.XB, F.g_norm_ffn + D, mod + 4096, mod + 3072, F.HB8R, F.WR8, F.b_router, F.RL); }
            if (MK_PER_PHASE || F.G != T / 128) SEAM(16);
            if (IN(17)) REP(17) { REFRESH(); route_count(F); }
            SEAM(17);
            if (IN(18)) REP(18) { REFRESH(); route_place(F); }
            SEAM(18);
            for (int s = 0; s < 2; ++s) {
                const int qb = 19 + 3 * s;
                if (IN(qb)) REP(qb) { REFRESH(); if (!(MOE_I8 && GATHER_OVERLAP)) { if (s == 0 || !GATHER_OVERLAP) route_gather(F, s, (int)blockIdx.x, F.G); } }
                if (!(MOE_I8 && GATHER_OVERLAP) && (s == 0 || !GATHER_OVERLAP)) SEAM(qb);
                if (IN(qb + 1)) REP(qb + 1) { STAGGER(1); const int nT = __builtin_amdgcn_readfirstlane(F.NT[s]);
#if MOE_I8
                    pg8::Gemm g{F.ASORT + (size_t)s * (T + 256) * (D / 2), F.WE1, T, 2 * FF, D / 2}; pg8::MoeOrder S; S.init(F.TILES + s * MAXTILES * 4, nT, 2 * FF / 256, F.G, (int)blockIdx.x, F.lds + RING_OFF, F.wave); MoeUpEpi E{F.HID, FF, F.SAS + s * (T + 256), F.SBFX + 2 * FF, F8_HS};
                    pg8::gemm_phase<MoeUpEpi, pg8::MoeOrder, PG8_ALIGN, PG8_SP2>(F.lds + RING_OFF, g, S, E, F.wave); }
#else
                    pg8::Gemm g{F.ASORT, F.WE1, T, 2 * FF, D}; pg8::MoeOrder S; S.init(F.TILES + s * MAXTILES * 4, nT, 2 * FF / 256, F.G, (int)blockIdx.x, F.lds + RING_OFF, F.wave); pg8::EpiSwiGLU E{F.HID, FF};
                    pg8::gemm_phase<pg8::EpiSwiGLU, pg8::MoeOrder, PG8_ALIGN, PG8_SP2>(F.lds + RING_OFF, g, S, E, F.wave); }
#endif
                SEAM(qb + 1);
                if (IN(qb + 2)) REP(qb + 2) { const int nT = __builtin_amdgcn_readfirstlane(F.NT[s]);
                    pg8::Gemm g{F.HID, F.WE2, T, D, FP8_MOE ? FF / 2 : FF}; pg8::EpiDeltaF8 E; E.d0 = (signed char*)(s ? F.D1 : F.D0A); E.pw = F.PW + s * T; E.osc = 1.f / (F8_HS * F8_WS); E.dsc = F8_DS;

                    const bool tail_ = (s == 1 && MOE_TAIL && F.G == 256 && nT > 128);
                    { pg8::MoeOrder S; S.init(F.TILES + s * MAXTILES * 4, tail_ ? 128 : nT, D / 256, F.G, (int)blockIdx.x, F.lds + RING_OFF, F.wave);
                      pg8::gemm_phase<pg8::EpiDeltaF8, pg8::MoeOrder, PG8_ALIGN, PG8_SP2>(F.lds + RING_OFF, g, S, E, F.wave); }
                    if (tail_) {
                        int c2 = (int)blockIdx.x; asm volatile("" : "+s"(c2));
                        pg8::MoeSliceOrder S2; S2.init(F.TILES + s * MAXTILES * 4, nT, D / 256, F.G, c2, MOE_DOWN_KT, PART_SLOTS); MoePartEpi E2; E2.part = F.PART;
                        pg8::gemm_phase<MoePartEpi, pg8::MoeSliceOrder, PG8_ALIGN, PG8_SP2>(F.lds + RING_OFF, g, S2, E2, F.wave); }
                }
                SEAM(qb + 2);
            }
        }
    }
    if (IN(25)) REP(25) { REFRESH(); final_norm(F); }
#undef IN
#undef SEAM
}

extern "C" void kernel_launch(void* const* d_in, const int* in_sizes, int n_in, void* d_out, int out_size, void* d_ws, size_t ws_size, hipStream_t stream) {
    static int grid = 0;
    if (grid == 0) {
        if (n_in != 28 || in_sizes[0] != T * D || out_size != T * D || ws_size < WS_END) { fprintf(stderr, "kernel_launch: unexpected problem: n_in %d, in0 %d, out %d, ws %zu (need %zu); nothing launched\n", n_in, n_in > 0 ? in_sizes[0] : -1, out_size, ws_size, (size_t)WS_END); grid = -1; return; }
        int dev = 0, cus = 0, per_cu = 0;
        if (hipGetDevice(&dev) != hipSuccess || hipDeviceGetAttribute(&cus, hipDeviceAttributeMultiprocessorCount, dev) != hipSuccess) { fprintf(stderr, "kernel_launch: device query failed\n"); grid = -1; return; }
        if (hipFuncSetAttribute((const void*)skel_fwd, hipFuncAttributeMaxDynamicSharedMemorySize, LDS_BYTES) != hipSuccess) { fprintf(stderr, "kernel_launch: hipFuncSetAttribute failed\n"); grid = -1; return; }
        if (hipOccupancyMaxActiveBlocksPerMultiprocessor(&per_cu, (const void*)skel_fwd, NWAVES * 64, LDS_BYTES) != hipSuccess || per_cu < 1) fprintf(stderr, "kernel_launch: note: occupancy query reports %d workgroups per CU\n", per_cu);
        (void)hipGetLastError();
        grid = cus;
    }
    if (grid < 0) return;
    if (hipMemsetAsync((char*)d_ws + WS_CTL, 0, CTL_ZERO_BYTES, stream) != hipSuccess) { fprintf(stderr, "kernel_launch: memset failed\n"); return; }
    Args a{};
    for (int i = 0; i < 28; ++i) a.in[i] = (const float*)d_in[i];
    a.out = (float*)d_out; a.ws = (unsigned char*)d_ws;
#if MK_PER_PHASE
    for (int ph = 0; ph < NPH; ++ph) { a.ph_lo = ph; a.ph_hi = ph + 1; hipLaunchKernelGGL(skel_fwd, dim3(grid), dim3(NWAVES * 64), LDS_BYTES, stream, a); }
#else
#ifdef SPLITMASK
    { int lo = 0;
      for (int k = 0; k < NPH; ++k) if (((unsigned)SPLITMASK >> k) & 1u) { a.ph_lo = lo; a.ph_hi = k + 1; a.dummy = SPLITDUP; hipLaunchKernelGGL(skel_fwd, dim3(grid), dim3(NWAVES * 64), LDS_BYTES, stream, a);
          hipMemsetAsync((char*)d_ws + WS_CTL, 0, CTL_ZERO_BYTES, stream); lo = SPLITDUP ? k : k + 1; }
      a.ph_lo = lo; a.ph_hi = NPH; a.dummy = 0; hipLaunchKernelGGL(skel_fwd, dim3(grid), dim3(NWAVES * 64), LDS_BYTES, stream, a); }
#else
    a.ph_lo = 0; a.ph_hi = NPH; hipLaunchKernelGGL(skel_fwd, dim3(grid), dim3(NWAVES * 64), LDS_BYTES, stream, a);
#endif
#endif
    const hipError_t le = hipPeekAtLastError();
    if (le != hipSuccess) fprintf(stderr, "kernel_launch: launch failed: %s\n", hipGetErrorName(le));
}
```
